# Optimizing an MI355X kernel written in HIP

```python
import math
import jax, jax.numpy as jnp
from jax import lax
import numpy as np

D_MODEL = 2048
BATCH = 4
SEQ = 4096
DEPTH = 2

N_A = DEPTH // 2
N_B = DEPTH - N_A
H_A = 16
HD_A = D_MODEL // H_A
QBLOCK = 128
HD_B = 64
H_B = D_MODEL // HD_B
KVH_B = H_B // 8
G_B = H_B // KVH_B
WINDOW = 128
ROPE_THETA = 10000.0
N_EXPERTS = 64
TOP_K = 8
N_GROUPS = 8
TOPK_GROUPS = 4
EXPERT_HIDDEN = 512
SHARED_HIDDEN = 512
ROUTED_SCALE = 2.5
MOE_BLOCK = 128
ALPHA = float((2 * DEPTH) ** 0.25)
BETA = float((8 * DEPTH) ** -0.25)
LN_EPS = 1e-5

kernel_name = "yoco_fox_swa_sink_moe_deepnorm"


def layer_norm(x, g, b):
    xf = x.astype(jnp.float32)
    mu = jnp.mean(xf, axis=-1, keepdims=True)
    var = jnp.mean(jnp.square(xf - mu), axis=-1, keepdims=True)
    y = (xf - mu) * lax.rsqrt(var + LN_EPS) * g.astype(jnp.float32) + b.astype(jnp.float32)
    return y.astype(x.dtype)


def rope(x, pos):
    hd = x.shape[-1]
    half = hd // 2
    inv = 1.0 / (ROPE_THETA ** (jnp.arange(half, dtype=jnp.float32) / half))
    ang = pos[:, None] * inv[None, :]
    cos = jnp.cos(ang)[None, :, None, :]
    sin = jnp.sin(ang)[None, :, None, :]
    xf = x.astype(jnp.float32)
    x1, x2 = xf[..., :half], xf[..., half:]
    out = jnp.concatenate([x1 * cos - x2 * sin, x2 * cos + x1 * sin], axis=-1)
    return out.astype(x.dtype)


def fox_attention(q, k, v, cum):
    B, S, H, hd = q.shape
    nb = S // QBLOCK
    scale = 1.0 / math.sqrt(hd)
    qb = q.reshape(B, nb, QBLOCK, H, hd).transpose(1, 0, 2, 3, 4)
    cb = cum.reshape(B, H, nb, QBLOCK).transpose(2, 0, 1, 3)
    key_pos = jnp.arange(S)

    def block(args):
        qi, ci, i = args
        s = jnp.einsum('bqhd,bkhd->bhqk', qi, k, preferred_element_type=jnp.float32) * scale
        s = s + ci[..., :, None] - cum[:, :, None, :]
        qpos = i * QBLOCK + jnp.arange(QBLOCK)
        mask = key_pos[None, :] <= qpos[:, None]
        s = jnp.where(mask[None, None], s, -jnp.inf)
        p = jax.nn.softmax(s, axis=-1)
        return jnp.einsum('bhqk,bkhd->bqhd', p.astype(v.dtype), v)

    out = lax.map(block, (qb, cb, jnp.arange(nb)))
    return out.transpose(1, 0, 2, 3, 4).reshape(B, S, H * hd)


def swa_attention(q, k, v, sinks):
    B, S, H, hd = q.shape
    nb = S // WINDOW
    scale = 1.0 / math.sqrt(hd)
    kp = jnp.pad(k, ((0, 0), (WINDOW, 0), (0, 0), (0, 0)))
    vp = jnp.pad(v, ((0, 0), (WINDOW, 0), (0, 0), (0, 0)))
    qg = q.reshape(B, nb, WINDOW, KVH_B, G_B, hd).transpose(1, 0, 2, 3, 4, 5)
    sink = sinks.astype(jnp.float32).reshape(KVH_B, G_B)[None, :, :, None, None]

    def block(args):
        qi, i = args
        ki = lax.dynamic_slice_in_dim(kp, i * WINDOW, 2 * WINDOW, axis=1)
        vi = lax.dynamic_slice_in_dim(vp, i * WINDOW, 2 * WINDOW, axis=1)
        s = jnp.einsum('bqkgd,bskd->bkgqs', qi, ki, preferred_element_type=jnp.float32) * scale
        qpos = i * WINDOW + jnp.arange(WINDOW)
        kpos = i * WINDOW - WINDOW + jnp.arange(2 * WINDOW)
        diff = qpos[:, None] - kpos[None, :]
        mask = (diff >= 0) & (diff < WINDOW) & (kpos[None, :] >= 0)
        s = jnp.where(mask, s, -jnp.inf)
        m = jnp.maximum(jnp.max(s, axis=-1, keepdims=True), sink)
        p = jnp.exp(s - m)
        p = p / (jnp.sum(p, axis=-1, keepdims=True) + jnp.exp(sink - m))
        return jnp.einsum('bkgqs,bskd->bqkgd', p.astype(vi.dtype), vi)

    out = lax.map(block, (qg, jnp.arange(nb)))
    return out.transpose(1, 0, 2, 3, 4, 5).reshape(B, S, H * hd)


def fox_layer(x, w_in, b_f, w_o):
    B, S, D = x.shape
    proj = x @ w_in
    q = proj[..., :D].reshape(B, S, H_A, HD_A)
    k = proj[..., D:2 * D].reshape(B, S, H_A, HD_A)
    v = proj[..., 2 * D:3 * D].reshape(B, S, H_A, HD_A)
    f = proj[..., 3 * D:]
    logf = jax.nn.log_sigmoid((f + b_f).astype(jnp.float32))
    cum = jnp.cumsum(logf, axis=1).transpose(0, 2, 1)
    return fox_attention(q, k, v, cum) @ w_o


def swa_layer(x, k_sh, v_sh, w_q, sinks, w_o, pos):
    B, S, D = x.shape
    q = rope((x @ w_q).reshape(B, S, H_B, HD_B), pos)
    return swa_attention(q, k_sh, v_sh, sinks) @ w_o


def moe(x, router_w, router_bias, w_gu, w_down, s_gu, s_down):
    B, S, D = x.shape
    xt = x.reshape(-1, D)
    T = xt.shape[0]
    logits = jnp.einsum('td,de->te', xt, router_w, preferred_element_type=jnp.float32)
    scores = jax.nn.sigmoid(logits)
    choice = scores + router_bias.astype(jnp.float32)
    grp = choice.reshape(T, N_GROUPS, N_EXPERTS // N_GROUPS)
    gscore = jnp.sum(lax.top_k(grp, 2)[0], axis=-1)
    _, gidx = lax.top_k(gscore, TOPK_GROUPS)
    gmask = jnp.sum(jax.nn.one_hot(gidx, N_GROUPS, dtype=jnp.int32), axis=1) > 0
    emask = jnp.repeat(gmask, N_EXPERTS // N_GROUPS, axis=1)
    _, eidx = lax.top_k(jnp.where(emask, choice, -jnp.inf), TOP_K)
    wts = jnp.take_along_axis(scores, eidx, axis=1)
    wts = wts / jnp.sum(wts, axis=-1, keepdims=True) * ROUTED_SCALE
    M = T * TOP_K
    M_PAD = M + N_EXPERTS * MOE_BLOCK
    NB = M_PAD // MOE_BLOCK
    flat_e = eidx.reshape(-1)
    flat_tok = jnp.repeat(jnp.arange(T, dtype=jnp.int32), TOP_K)
    flat_w = wts.reshape(-1).astype(xt.dtype)
    order = jnp.argsort(flat_e)
    sorted_e = flat_e[order]
    counts = jnp.bincount(flat_e, length=N_EXPERTS)
    padded = ((counts + MOE_BLOCK - 1) // MOE_BLOCK) * MOE_BLOCK
    ends_pad = jnp.cumsum(padded)
    starts_pad = ends_pad - padded
    starts = jnp.cumsum(counts) - counts
    dest = starts_pad[sorted_e] + (jnp.arange(M) - starts[sorted_e])
    tok_pad = jnp.zeros((M_PAD,), jnp.int32).at[dest].set(flat_tok[order])
    gate_pad = jnp.zeros((M_PAD,), xt.dtype).at[dest].set(flat_w[order])
    block_e = jnp.clip(jnp.searchsorted(ends_pad, jnp.arange(NB) * MOE_BLOCK, side='right'),
                       0, N_EXPERTS - 1)

    def body(acc, blk):
        tok, g, e = blk
        h = xt[tok]
        gu = h @ w_gu[e]
        a = jax.nn.silu(gu[:, :EXPERT_HIDDEN]) * gu[:, EXPERT_HIDDEN:]
        y = (a @ w_down[e]) * g[:, None]
        return acc.at[tok].add(y), None

    routed, _ = lax.scan(body, jnp.zeros_like(xt),
                         (tok_pad.reshape(NB, MOE_BLOCK), gate_pad.reshape(NB, MOE_BLOCK), block_e))
    sg = xt @ s_gu
    shared = (jax.nn.silu(sg[:, :SHARED_HIDDEN]) * sg[:, SHARED_HIDDEN:]) @ s_down
    return (routed + shared).reshape(B, S, D)


def setup_inputs(seed: int = 0) -> dict:
    key = jax.random.key(seed)
    ks = jax.random.split(key, 20)
    D = D_MODEL
    f32 = jnp.float32
    nrm = lambda k, shp, s: jax.random.normal(k, shp, f32) * s
    return {
        "x": jax.random.normal(ks[0], (BATCH, SEQ, D), f32),
        "a_w_in": nrm(ks[1], (N_A, D, 3 * D + H_A), D ** -0.5),
        "a_b_f": jax.random.uniform(ks[2], (N_A, H_A), f32, 1.0, 4.0),
        "a_w_o": nrm(ks[3], (N_A, D, D), D ** -0.5 * BETA),
        "kv_w": nrm(ks[4], (D, 2 * KVH_B * HD_B), D ** -0.5),
        "b_w_q": nrm(ks[5], (N_B, D, H_B * HD_B), D ** -0.5),
        "b_sinks": nrm(ks[6], (N_B, H_B), 0.5),
        "b_w_o": nrm(ks[7], (N_B, H_B * HD_B, D), (H_B * HD_B) ** -0.5 * BETA),
        "router_w": nrm(ks[8], (DEPTH, D, N_EXPERTS), D ** -0.5),
        "router_bias": nrm(ks[9], (DEPTH, N_EXPERTS), 0.01),
        "moe_w_gu": nrm(ks[10], (DEPTH, N_EXPERTS, D, 2 * EXPERT_HIDDEN), D ** -0.5),
        "moe_w_down": nrm(ks[11], (DEPTH, N_EXPERTS, EXPERT_HIDDEN, D), EXPERT_HIDDEN ** -0.5 * BETA),
        "shared_w_gu": nrm(ks[12], (DEPTH, D, 2 * SHARED_HIDDEN), D ** -0.5),
        "shared_w_down": nrm(ks[13], (DEPTH, SHARED_HIDDEN, D), SHARED_HIDDEN ** -0.5 * BETA),
        "ln1_g": 1.0 + nrm(ks[14], (DEPTH, D), 0.02),
        "ln1_b": nrm(ks[15], (DEPTH, D), 0.02),
        "ln2_g": 1.0 + nrm(ks[16], (DEPTH, D), 0.02),
        "ln2_b": nrm(ks[17], (DEPTH, D), 0.02),
    }


def reference(x, a_w_in, a_b_f, a_w_o, kv_w, b_w_q, b_sinks, b_w_o, router_w, router_bias,
              moe_w_gu, moe_w_down, shared_w_gu, shared_w_down, ln1_g, ln1_b, ln2_g, ln2_b):
    B, S, D = x.shape
    pos = jnp.arange(S, dtype=jnp.float32)
    k_sh = None
    v_sh = None
    for i in range(DEPTH):
        if i < N_A:
            h = fox_layer(x, a_w_in[i], a_b_f[i], a_w_o[i])
        else:
            j = i - N_A
            h = swa_layer(x, k_sh, v_sh, b_w_q[j], b_sinks[j], b_w_o[j], pos)
        x = layer_norm(ALPHA * x + h, ln1_g[i], ln1_b[i])
        x = layer_norm(ALPHA * x + moe(x, router_w[i], router_bias[i], moe_w_gu[i], moe_w_down[i],
                                       shared_w_gu[i], shared_w_down[i]), ln2_g[i], ln2_b[i])
        if i == N_A - 1:
            kv = x @ kv_w
            k_sh = rope(kv[..., :KVH_B * HD_B].reshape(B, S, KVH_B, HD_B), pos)
            v_sh = kv[..., KVH_B * HD_B:].reshape(B, S, KVH_B, HD_B)
    return x
```

```cpp
#include <hip/hip_runtime.h>
#include <hip/hip_bf16.h>
#include <cstdio>
#include <cstdint>
#include <cmath>
#define MK_PER_PHASE 0
namespace pg8 {
#define PG8_LAS __attribute__((address_space(3)))
typedef unsigned short bf16_t;
typedef short bf16x8 __attribute__((ext_vector_type(8)));
typedef float f32x4 __attribute__((ext_vector_type(4)));
typedef unsigned u32x4 __attribute__((ext_vector_type(4)));
typedef int v8i __attribute__((ext_vector_type(8)));
typedef unsigned u32x2 __attribute__((ext_vector_type(2)));
constexpr int BM = 256, BK = 64, HALF = 128, HTB = HALF * BK * 2  , STAGE_BYTES = 8 * HTB, NXCD = 8, WGM = 8;

__host__ __device__ __forceinline__ int lds_byte(int r, int c) { const int st = (r >> 4) * 2 + (c >> 5), rr = r & 15, cc = c & 31, ob = rr * 64 + cc * 2; return st * 1024 + (ob ^ (((ob >> 9) & 1) << 5)); }
__host__ __device__ __forceinline__ void stage_rc(int b, int& R, int& C) { const int st = b / 1024, sb = b % 1024, swz = sb ^ (((sb >> 9) & 1) << 5); R = (st >> 1) * 16 + swz / 64; C = (st & 1) * 32 + (swz % 64) / 2; }
__host__ __device__ __forceinline__ int perm32(int rho) { const int n = rho >> 4, i = rho & 15; return 8 * (i >> 2) + 4 * n + (i & 3); }

struct Unit { int pm, pn, pb; };
struct Gemm { const bf16_t* A; const bf16_t* Bt; int K; const int* rowtab; };

struct StaticOrder {
    int nM, nN, nwg, G, c;
    __host__ __device__ void init(int M, int N, int G_, int c_) { nM = M / BM; nN = N / BM; nwg = nM * nN; G = G_; c = c_; }
    __host__ __device__ bool next(int i, Unit& u) const {
        const long L = (long)i * G + c; if (L >= nwg) return false;
        int wgid = (int)L; { const int q = nwg / NXCD, r = nwg % NXCD, xcd = wgid % NXCD, off = wgid / NXCD; wgid = (xcd < r ? xcd * (q + 1) : r * (q + 1) + (xcd - r) * q) + off; }
        const int nig = WGM * nN, gid = wgid / nig, fm = gid * WGM, gsz = (nM - fm) < WGM ? (nM - fm) : WGM;
        u.pm = fm + ((wgid % nig) % gsz); u.pn = (wgid % nig) / gsz; u.pb = u.pn; return true;
    }
};
struct GroupedOrder {
    int nN, nwg, G, c; const int* tile_e;
    __device__ void init(int ntiles, int nN_, int G_, int c_, const int* te) { nN = nN_; nwg = ntiles * nN_; G = G_; c = c_; tile_e = te; }
    __device__ bool next(int i, Unit& u) const {
        const long L = (long)i * G + c; if (L >= nwg) return false;
        int wgid = (int)L; { const int q = nwg / NXCD, r = nwg % NXCD, xcd = wgid % NXCD, off = wgid / NXCD; wgid = (xcd < r ? xcd * (q + 1) : r * (q + 1) + (xcd - r) * q) + off; }
        const int t = wgid / nN; u.pm = t; u.pn = wgid - t * nN; u.pb = __builtin_amdgcn_readfirstlane(tile_e[t]) * nN + u.pn; return true;
    }
};

__device__ __forceinline__ unsigned cvt_pk_bf16(float lo, float hi) { unsigned r; asm volatile("v_cvt_pk_bf16_f32 %0, %1, %2" : "=v"(r) : "v"(lo), "v"(hi)); return r; }

template <bool NT> struct EpiBf16T {
    static constexpr int PERM = 1; static constexpr int NST = 16; static constexpr int WSCALE8 = 0x7F7F7F7F;
    bf16_t* O; int ldc; int split_cols; size_t split_stride; float scale0;
    __device__ __forceinline__ void operator()(const f32x4 (&acc)[2][2][4][2], const Unit& u, int wr, int wc, int fr, int fq) const {
        const int row0 = u.pm * BM + wr * 64 + fr; int colt = u.pn * BM; bf16_t* base = O;
        float sc = 1.f; if (split_cols) { const int t = colt / split_cols; base += (size_t)t * split_stride; colt -= t * split_cols; if (t == 0) sc = scale0; }
        const int col0 = colt + wc * 32 + 8 * fq;
#pragma unroll
        for (int ai = 0; ai < 2; ++ai)
#pragma unroll
            for (int m = 0; m < 4; ++m) { bf16_t* rowp = base + (size_t)(row0 + ai * HALF + m * 16) * ldc + col0;
#pragma unroll
                for (int bj = 0; bj < 2; ++bj) { f32x4 v0 = acc[ai][bj][m][0] * sc, v1 = acc[ai][bj][m][1] * sc;
                    u32x4 w; w.x = cvt_pk_bf16(v0[0], v0[1]); w.y = cvt_pk_bf16(v0[2], v0[3]); w.z = cvt_pk_bf16(v1[0], v1[1]); w.w = cvt_pk_bf16(v1[2], v1[3]);
                    if constexpr (NT) __builtin_nontemporal_store(w, (u32x4*)(rowp + bj * HALF)); else *(u32x4*)(rowp + bj * HALF) = w; } }
    }
};
typedef EpiBf16T<false> EpiBf16; typedef EpiBf16T<true> EpiBf16NT;
struct EpiQKVn {
    static constexpr int PERM = 1; static constexpr int NST = 16; static constexpr int WSCALE8 = 0x7F7F7F7F;
    bf16_t* O; size_t split_stride; float scale0; float* nq; float* nk;
    __device__ __forceinline__ void operator()(const f32x4 (&acc)[2][2][4][2], const Unit& u, int wr, int wc, int fr, int fq) const {
        const int row0 = u.pm * BM + wr * 64 + fr; int colt = u.pn * BM; const int t = colt / 2048; bf16_t* base = O + (size_t)t * split_stride; colt -= t * 2048;
        const float sc = t == 0 ? scale0 : 1.f; float* nrm = t == 0 ? nq : nk;
        const int col0 = colt + wc * 32 + 8 * fq;
#pragma unroll
        for (int ai = 0; ai < 2; ++ai)
#pragma unroll
            for (int m = 0; m < 4; ++m) { const int row = row0 + ai * HALF + m * 16; bf16_t* rowp = base + (size_t)row * 2048 + col0;
#pragma unroll
                for (int bj = 0; bj < 2; ++bj) { f32x4 v0 = acc[ai][bj][m][0] * sc, v1 = acc[ai][bj][m][1] * sc;
                    u32x4 w; w.x = cvt_pk_bf16(v0[0], v0[1]); w.y = cvt_pk_bf16(v0[2], v0[3]); w.z = cvt_pk_bf16(v1[0], v1[1]); w.w = cvt_pk_bf16(v1[2], v1[3]);
                    *(u32x4*)(rowp + bj * HALF) = w;
                    if (t < 2) { float ss = (v0[0] * v0[0] + v0[1] * v0[1]) + (v0[2] * v0[2] + v0[3] * v0[3]) + (v1[0] * v1[0] + v1[1] * v1[1]) + (v1[2] * v1[2] + v1[3] * v1[3]);
                        ss += __shfl_xor(ss, 16); ss += __shfl_xor(ss, 32);
                        if (fq == 0) { const int head = (colt >> 7) + bj; atomicAdd(nrm + ((size_t)((row >> 12) * 16 + head) << 12) + (row & 4095), ss); } } } }
    }
};
struct EpiSwiglu {
    static constexpr int PERM = 1; static constexpr int NST = 8; static constexpr int WSCALE8 = 0x7F7F7F7F;
    bf16_t* O; int ldc;
    __device__ __forceinline__ void operator()(const f32x4 (&acc)[2][2][4][2], const Unit& u, int wr, int wc, int fr, int fq) const {
        const int col0 = u.pn * HALF + wc * 32 + 8 * fq;
#pragma unroll
        for (int ai = 0; ai < 2; ++ai)
#pragma unroll
            for (int m = 0; m < 4; ++m) { bf16_t* rowp = O + (size_t)(u.pm * BM + ai * HALF + wr * 64 + m * 16 + fr) * ldc + col0;
                float a[8];
#pragma unroll
                for (int n = 0; n < 2; ++n)
#pragma unroll
                    for (int j = 0; j < 4; ++j) { const float g = acc[ai][0][m][n][j], up = acc[ai][1][m][n][j];
                        a[n * 4 + j] = g * __builtin_amdgcn_rcpf(1.f + __builtin_amdgcn_exp2f(-1.4426950408889634f * g)) * up; }
                u32x4 w; w.x = cvt_pk_bf16(a[0], a[1]); w.y = cvt_pk_bf16(a[2], a[3]); w.z = cvt_pk_bf16(a[4], a[5]); w.w = cvt_pk_bf16(a[6], a[7]);
                *(u32x4*)rowp = w; }
    }
};
__device__ __forceinline__ unsigned pk4_fp8(float a, float b, float c, float d) { int w = 0; w = __builtin_amdgcn_cvt_pk_fp8_f32(a, b, w, false); w = __builtin_amdgcn_cvt_pk_fp8_f32(c, d, w, true); return (unsigned)w; }
struct EpiFp8Y {
    static constexpr int PERM = 2; static constexpr int NST = 8; static constexpr int WSCALE8 = 0x7D7D7D7D;
    unsigned char* O; int ldc;
    __device__ __forceinline__ void operator()(const f32x4 (&acc)[2][2][4][2], const Unit& u, int wr, int wc, int fr, int fq) const {
        const int col0 = u.pn * BM + wc * 64 + 16 * fq;
#pragma unroll
        for (int ai = 0; ai < 2; ++ai)
#pragma unroll
            for (int m = 0; m < 4; ++m) { unsigned char* rowp = O + (size_t)(u.pm * BM + ai * HALF + wr * 64 + m * 16 + fr) * ldc + col0;
                const f32x4 a = acc[ai][0][m][0], b = acc[ai][0][m][1], c = acc[ai][1][m][0], d = acc[ai][1][m][1];
                u32x4 w; w.x = pk4_fp8(a[0], a[1], a[2], a[3]); w.y = pk4_fp8(b[0], b[1], b[2], b[3]); w.z = pk4_fp8(c[0], c[1], c[2], c[3]); w.w = pk4_fp8(d[0], d[1], d[2], d[3]);
                *(u32x4*)rowp = w; }
    }
};
struct EpiSwiglu8 {
    static constexpr int PERM = 1; static constexpr int NST = 8; static constexpr int WSCALE8 = 0x79797979;
    unsigned char* O; int ldc; float iscale;
    __device__ __forceinline__ void operator()(const f32x4 (&acc)[2][2][4][2], const Unit& u, int wr, int wc, int fr, int fq) const {
        const int col0 = u.pn * HALF + wc * 32 + 8 * fq;
#pragma unroll
        for (int ai = 0; ai < 2; ++ai)
#pragma unroll
            for (int m = 0; m < 4; ++m) { unsigned char* rowp = O + (size_t)(u.pm * BM + ai * HALF + wr * 64 + m * 16 + fr) * ldc + col0;
                float a[8];
#pragma unroll
                for (int n = 0; n < 2; ++n)
#pragma unroll
                    for (int j = 0; j < 4; ++j) { const float g = acc[ai][0][m][n][j] * iscale, up = acc[ai][1][m][n][j] * iscale;
                        a[n * 4 + j] = g * __builtin_amdgcn_rcpf(1.f + __builtin_amdgcn_exp2f(-1.4426950408889634f * g)) * up; }
                u32x2 w; w.x = pk4_fp8(a[0], a[1], a[2], a[3]); w.y = pk4_fp8(a[4], a[5], a[6], a[7]);
                *(u32x2*)rowp = w; }
    }
};
struct EpiRope {
    static constexpr int PERM = 1; static constexpr int NST = 16; static constexpr int WSCALE8 = 0x7F7F7F7F;
    bf16_t* Q; bf16_t* Kc; bf16_t* Vc; const float* cs; const float* sn; float qscale;
    __device__ __forceinline__ void operator()(const f32x4 (&acc)[2][2][4][2], const Unit& u, int wr, int wc, int fr, int fq) const {
        if (u.pn == 9) {
#pragma unroll
            for (int ai = 0; ai < 2; ++ai)
#pragma unroll
                for (int m = 0; m < 4; ++m) { bf16_t* rowp = Vc + (size_t)(u.pm * BM + ai * HALF + wr * 64 + m * 16 + fr) * 256 + wc * 32 + 8 * fq;
#pragma unroll
                    for (int bj = 0; bj < 2; ++bj) { const f32x4 v0 = acc[ai][bj][m][0], v1 = acc[ai][bj][m][1];
                        u32x4 w; w.x = cvt_pk_bf16(v0[0], v0[1]); w.y = cvt_pk_bf16(v0[2], v0[3]); w.z = cvt_pk_bf16(v1[0], v1[1]); w.w = cvt_pk_bf16(v1[2], v1[3]);
                        *(u32x4*)(rowp + bj * HALF) = w; } }
            return;
        }
        const bool isq = u.pn < 8; const float sc = isq ? qscale : 1.f;
        bf16_t* base = isq ? Q + u.pn * 256 : Kc; const int ldo = isq ? 2048 : 256;
#pragma unroll
        for (int ai = 0; ai < 2; ++ai)
#pragma unroll
            for (int m = 0; m < 4; ++m) { int fq_ = fq; asm volatile("" : "+v"(fq_)); const int row = u.pm * BM + ai * HALF + wr * 64 + m * 16 + fr; const int pos = row & 4095;
                const unsigned to_ = (unsigned)(pos * 32 + 8 * fq_) * 4u;
                const f32x4 c0 = *(const f32x4*)((const char*)cs + to_), c1 = *(const f32x4*)((const char*)cs + to_ + 16);
                const f32x4 s0 = *(const f32x4*)((const char*)sn + to_), s1 = *(const f32x4*)((const char*)sn + to_ + 16);
                const f32x4 a0 = acc[ai][0][m][0], a1 = acc[ai][0][m][1], b0 = acc[ai][1][m][0], b1 = acc[ai][1][m][1];
                const f32x4 x0 = (a0 * c0 - b0 * s0) * sc, x1 = (a1 * c1 - b1 * s1) * sc, y0 = (b0 * c0 + a0 * s0) * sc, y1 = (b1 * c1 + a1 * s1) * sc;
                bf16_t* rowp = base + (size_t)row * ldo + wc * 64 + 8 * fq_;
                u32x4 w; w.x = cvt_pk_bf16(x0[0], x0[1]); w.y = cvt_pk_bf16(x0[2], x0[3]); w.z = cvt_pk_bf16(x1[0], x1[1]); w.w = cvt_pk_bf16(x1[2], x1[3]);
                *(u32x4*)rowp = w;
                w.x = cvt_pk_bf16(y0[0], y0[1]); w.y = cvt_pk_bf16(y0[2], y0[3]); w.z = cvt_pk_bf16(y1[0], y1[1]); w.w = cvt_pk_bf16(y1[2], y1[3]);
                *(u32x4*)(rowp + 32) = w;
                if (m & 1) asm volatile("" ::: "memory"); }
    }
};

__device__ __forceinline__ void glds16s(const void* sbase, unsigned voff, unsigned lds_dst) { unsigned keep;
    asm volatile("s_mov_b32 %0, m0\n\ts_mov_b32 m0, %3\n\ts_nop 0\n\tglobal_load_lds_dwordx4 %1, %2\n\ts_mov_b32 m0, %0" : "=&s"(keep) : "v"(voff), "s"(sbase), "s"(lds_dst) : "memory"); }
template <class Epi, class Sched, bool ALIGN_EPI, bool GATHER, bool FP8 = false>
__device__ __forceinline__ void gemm_phase(PG8_LAS unsigned char* lds, const Gemm g, const Sched& S, const Epi& E) {
    const int tid = threadIdx.x, wid = __builtin_amdgcn_readfirstlane(tid >> 6), lane = tid & 63, wr = wid >> 2, wc = wid & 3, fr = lane & 15, fq = lane >> 4;
    int K = g.K; if constexpr (FP8) asm volatile("" : "+s"(K)); const int nt = K / BK;
    unsigned voffB[2][2], vcur[2][2], vnxt[2][2];
    constexpr int PM = (int)Epi::PERM;
#pragma unroll
    for (int i = 0; i < 2; ++i) { int R, C; stage_rc(tid * 16 + i * 8192, R, C);
        if constexpr (PM == 2) { const int w_ = R >> 5, n_ = (R >> 4) & 1, q_ = (R >> 2) & 3, r_ = R & 3;
#pragma unroll
            for (int h = 0; h < 2; ++h) voffB[h][i] = (unsigned)((64 * w_ + 16 * q_ + 8 * h + 4 * n_ + r_) * K + C) * 2u; }
        else { const int Rb = PM ? ((R & ~31) + perm32(R & 31)) : R; voffB[0][i] = (unsigned)(Rb * K + C) * 2u; voffB[1][i] = voffB[0][i] + (unsigned)(HALF * K * 2); } }
    const size_t kstep = (size_t)(BK * 2);
    const size_t hstep = (size_t)HALF * K * 2;
    const size_t tstep = 2 * hstep;
    const unsigned ldsw = (unsigned)wid * 1024u; const unsigned ldsa = (unsigned)__builtin_amdgcn_readfirstlane((int)((unsigned)(uintptr_t)lds + (unsigned)wid * 1024u));
    const int aoff = lds_byte(wr * 64 + fr, fq * 8), boff = lds_byte(wc * 32 + fr, fq * 8);
#define PG8_SA(b, h) (((b) * 2 + (h)) * HTB)
#define PG8_SB(b, h) ((4 + (b) * 2 + (h)) * HTB)
#define PG8_STAGE(bufoff, gbase, voff) do { _Pragma("unroll") for (int _i = 0; _i < 2; ++_i) { \
        glds16s((const void*)(gbase), (voff)[_i], ldsa + (unsigned)((bufoff) + _i * 8192)); } } while (0)
#define PG8_STAGE_A1(bufoff, gbase, voff2) do { if constexpr (GATHER) PG8_STAGE(bufoff, gbase, (voff2)[1]); else PG8_STAGE(bufoff, (gbase) + hstep, (voff2)[0]); } while (0)
#define PG8_STAGE_B1(bufoff, gbase) do { if constexpr (PM == 2) PG8_STAGE(bufoff, gbase, voffB[1]); else PG8_STAGE(bufoff, (gbase) + hstep, voffB[0]); } while (0)
#define PG8_LDA(dst, b, h) do { _Pragma("unroll") for (int m = 0; m < 4; ++m) _Pragma("unroll") for (int k = 0; k < 2; ++k) dst[m][k] = *(const PG8_LAS bf16x8*)(lds + PG8_SA(b, h) + aoff + m * 2048 + k * 1024); } while (0)
#define PG8_LDB(dst, b, h) do { _Pragma("unroll") for (int n = 0; n < 2; ++n) _Pragma("unroll") for (int k = 0; k < 2; ++k) dst[n][k] = *(const PG8_LAS bf16x8*)(lds + PG8_SB(b, h) + boff + n * 2048 + k * 1024); } while (0)
#define PG8_CAT8(x) __builtin_bit_cast(v8i, __builtin_shufflevector((x)[0], (x)[1], 0, 1, 2, 3, 4, 5, 6, 7, 8, 9, 10, 11, 12, 13, 14, 15))
#define PG8_MMA(ZC, ai, bj, At, Bt) do { __builtin_amdgcn_s_setprio(1); _Pragma("unroll") for (int m = 0; m < 4; ++m) _Pragma("unroll") for (int n = 0; n < 2; ++n) { \
        if constexpr (FP8) { if constexpr (ZC) asm volatile("v_mfma_scale_f32_16x16x128_f8f6f4 %0, %1, %2, 0, %3, %4 op_sel_hi:[0,0,0]" : "=&v"(acc[ai][bj][m][n]) : "v"(PG8_CAT8(Bt[n])), "v"(PG8_CAT8(At[m])), "v"(sc8w), "v"(sc8)); \
            else asm volatile("v_mfma_scale_f32_16x16x128_f8f6f4 %0, %1, %2, %0, %3, %4 op_sel_hi:[0,0,0]" : "+v"(acc[ai][bj][m][n]) : "v"(PG8_CAT8(Bt[n])), "v"(PG8_CAT8(At[m])), "v"(sc8w), "v"(sc8)); } \
        else { acc[ai][bj][m][n] = __builtin_amdgcn_mfma_f32_16x16x32_bf16(Bt[n][0], At[m][0], (ZC) ? (f32x4){0.f, 0.f, 0.f, 0.f} : acc[ai][bj][m][n], 0, 0, 0); \
               acc[ai][bj][m][n] = __builtin_amdgcn_mfma_f32_16x16x32_bf16(Bt[n][1], At[m][1], acc[ai][bj][m][n], 0, 0, 0); } } __builtin_amdgcn_s_setprio(0); } while (0)
#define PG8_WAIT_V(n) asm volatile("s_waitcnt vmcnt(" #n ")" ::: "memory")
#define PG8_WAIT_VN(n) asm volatile("s_waitcnt vmcnt(%0)" :: "i"(n) : "memory")
#define PG8_WAIT_L(n) asm volatile("s_waitcnt lgkmcnt(" #n ")" ::: "memory")
#define PG8_BAR __builtin_amdgcn_s_barrier()
#define PG8_SCHED __builtin_amdgcn_sched_barrier(0)
#define PG8_AOFFS(dst, u_) do { _Pragma("unroll") for (int _h = 0; _h < 2; ++_h) _Pragma("unroll") for (int _i = 0; _i < 2; ++_i) { int R_, C_; stage_rc(tid * 16 + _i * 8192, R_, C_); \
        if constexpr (GATHER) dst[_h][_i] = (unsigned)g.rowtab[(u_).pm * BM + _h * HALF + R_] * (unsigned)(K * 2) + (unsigned)C_ * 2u; \
        else dst[_h][_i] = (unsigned)(R_ * K) * 2u + (unsigned)C_ * 2u + (unsigned)(_h * hstep); } } while (0)
    Unit cur, nxt; int ui = 0;
    if (!S.next(0, cur)) return;
    f32x4 acc[2][2][4][2];
#pragma unroll
    for (int a = 0; a < 2; ++a)
#pragma unroll
        for (int b = 0; b < 2; ++b)
#pragma unroll
            for (int m = 0; m < 4; ++m)
#pragma unroll
                for (int n = 0; n < 2; ++n) acc[a][b][m][n] = (f32x4){0.f, 0.f, 0.f, 0.f};
    bf16x8 At[4][2], B0[2][2], B1[2][2]; const int sc8 = 0x7F7F7F7F; int sc8w = 0x7F7F7F7F; if constexpr (FP8) sc8w = Epi::WSCALE8;
    PG8_AOFFS(vcur, cur);
    const char* cA = GATHER ? (const char*)g.A : (const char*)g.A + (size_t)cur.pm * tstep; const char* cB = (const char*)g.Bt + (size_t)cur.pb * tstep;
    PG8_STAGE(PG8_SB(0, 0), cB, voffB[0]); PG8_STAGE_B1(PG8_SB(0, 1), cB); PG8_STAGE(PG8_SA(0, 0), cA, vcur[0]); PG8_STAGE_A1(PG8_SA(0, 1), cA, vcur);
    if (wr == 1) PG8_BAR;
    PG8_WAIT_V(2); PG8_BAR;
    PG8_STAGE(PG8_SB(1, 0), cB + kstep, voffB[0]); PG8_STAGE(PG8_SA(1, 0), cA + kstep, vcur[0]); PG8_STAGE_B1(PG8_SB(1, 1), cB + kstep); PG8_STAGE_A1(PG8_SA(1, 1), cA + kstep, vcur);
    PG8_WAIT_V(0); PG8_BAR;
    for (;;) {
        const bool has_next = S.next(ui + 1, nxt);
        const char* nA = GATHER ? (const char*)g.A : (has_next ? (const char*)g.A + (size_t)nxt.pm * tstep : cA); const char* nB = has_next ? (const char*)g.Bt + (size_t)nxt.pb * tstep : cB;
#pragma unroll
        for (int _h = 0; _h < 2; ++_h)
#pragma unroll
            for (int _i = 0; _i < 2; ++_i) vnxt[_h][_i] = vcur[_h][_i];
#define PG8_TRIP(FIRST, t_) do { const int t = (t_); const bool last = (t == nt - 2); \
            if constexpr (GATHER) { if (last && has_next) { PG8_AOFFS(vnxt, nxt); } }     \
            const char* a1 = cA + (size_t)(t + 1) * kstep; \
            const char* a2 = last ? nA : cA + (size_t)(t + 2) * kstep; const char* b2 = last ? nB : cB + (size_t)(t + 2) * kstep; \
            const char* a3 = a2 + kstep; const char* b3 = b2 + kstep; \
            unsigned s0[2], s1[2]; \
            _Pragma("unroll") for (int _i = 0; _i < 2; ++_i) { if constexpr (GATHER) { s0[_i] = last ? vnxt[0][_i] : vcur[0][_i]; s1[_i] = last ? vnxt[1][_i] : vcur[1][_i]; } else { s0[_i] = vcur[0][_i]; s1[_i] = vcur[1][_i]; } } \
              \
            PG8_LDB(B0, 0, 0); PG8_LDB(B1, 0, 1); PG8_SCHED; PG8_LDA(At, 0, 0); if constexpr (!(FIRST)) { PG8_STAGE_A1(PG8_SA(1, 1), a1, vcur); PG8_WAIT_V(8); } \
            PG8_WAIT_L(0); PG8_BAR; PG8_MMA(FIRST, 0, 0, At, B0); PG8_MMA(FIRST, 0, 1, At, B1); PG8_BAR; PG8_SCHED; \
              \
            PG8_LDA(At, 0, 1); PG8_STAGE(PG8_SB(0, 0), b2, voffB[0]); PG8_STAGE_B1(PG8_SB(0, 1), b2); PG8_STAGE(PG8_SA(0, 0), a2, s0); \
            if constexpr (FIRST) PG8_WAIT_VN(8 + Epi::NST); else PG8_WAIT_V(8); \
            PG8_WAIT_L(0); PG8_BAR; PG8_MMA(FIRST, 1, 0, At, B0); PG8_MMA(FIRST, 1, 1, At, B1); PG8_BAR; PG8_SCHED; \
              \
            PG8_LDB(B0, 1, 0); PG8_LDB(B1, 1, 1); PG8_SCHED; PG8_LDA(At, 1, 0); if constexpr (GATHER) PG8_STAGE(PG8_SA(0, 1), a2, s1); else PG8_STAGE(PG8_SA(0, 1), (a2) + hstep, s0); \
            if constexpr (FIRST) PG8_WAIT_VN(8 + Epi::NST); else PG8_WAIT_V(8); \
            PG8_WAIT_L(0); PG8_BAR; PG8_MMA(false, 0, 0, At, B0); PG8_MMA(false, 0, 1, At, B1); PG8_BAR; PG8_SCHED; \
              \
            PG8_LDA(At, 1, 1); PG8_STAGE(PG8_SB(1, 0), b3, voffB[0]); PG8_STAGE_B1(PG8_SB(1, 1), b3); PG8_STAGE(PG8_SA(1, 0), a3, s0); \
            PG8_WAIT_V(8); PG8_WAIT_L(0); PG8_BAR; PG8_MMA(false, 1, 0, At, B0); PG8_MMA(false, 1, 1, At, B1); PG8_BAR; PG8_SCHED; } while (0)
        PG8_TRIP(true, 0);
        for (int tt = 2; tt < nt; tt += 2) PG8_TRIP(false, tt);
        if constexpr (FP8) asm volatile("s_nop 15\n\ts_nop 15" ::: "memory");
        if constexpr (ALIGN_EPI) { if (wr == 0) PG8_BAR; }
        static_assert(ALIGN_EPI, "the pre-epilogue piece below needs both halves past their last LDS reads");
        if (has_next) { if constexpr (GATHER) PG8_STAGE(PG8_SA(1, 1), nA + kstep, vnxt[1]); else PG8_STAGE(PG8_SA(1, 1), nA + kstep + hstep, vcur[0]); }
        E(acc, cur, wr, wc, fr, fq);
        if (!has_next) break;
        cur = nxt; cA = nA; cB = nB; ++ui;
#pragma unroll
        for (int _h = 0; _h < 2; ++_h)
#pragma unroll
            for (int _i = 0; _i < 2; ++_i) vcur[_h][_i] = vnxt[_h][_i];
        if constexpr (ALIGN_EPI) { if (wr == 1) PG8_BAR; }
    }
    PG8_WAIT_V(0);
    if constexpr (!ALIGN_EPI) { if (wr == 0) PG8_BAR; }
    PG8_BAR;
#undef PG8_SA
#undef PG8_SB
#undef PG8_STAGE
#undef PG8_LDA
#undef PG8_STAGE_A1
#undef PG8_STAGE_B1
#undef PG8_LDB
#undef PG8_MMA
#undef PG8_CAT8
#undef PG8_WAIT_V
#undef PG8_WAIT_VN
#undef PG8_WAIT_L
#undef PG8_BAR
#undef PG8_SCHED
#undef PG8_AOFFS
#undef PG8_TRIP
}
}
#ifndef FOX_DOUBLE
#define FOX_DOUBLE 0
#endif
namespace fox {
using bf16 = __hip_bfloat16;
typedef short bf16x8 __attribute__((ext_vector_type(8)));
typedef short s16x4 __attribute__((ext_vector_type(4)));
typedef float f32x16 __attribute__((ext_vector_type(16)));
typedef float f32x4 __attribute__((ext_vector_type(4)));
typedef unsigned u32x4 __attribute__((ext_vector_type(4)));
constexpr int D = 128, LDQ = 2048, SEQ = 4096, NH = 16, NB = 4;
constexpr int NW = 8, QBLK = 32, KVBLK = 64, QB = NW * QBLK;
constexpr int SHM_V = KVBLK * D * 2, SHM_K = KVBLK * D * 2;
constexpr int OFF_WS = 2 * SHM_V + 2 * SHM_K, OFF_CB = OFF_WS + NW * 64 * 4, LDS_BYTES = OFF_CB + 2 * 64 * 4;
constexpr float THRL = 11.5f;

#define KSWZ(row, colB) ((row) * 256 + ((colB) ^ (((row) & 7) << 4)))
#define SBAR() __builtin_amdgcn_sched_barrier(0)
__device__ __forceinline__ int v_st(int k, int c) { const int kk = (k & ~0xC) | ((k & 4) << 1) | ((k & 8) >> 1); return ((kk >> 3) * 4 + (c >> 5)) * 512 + ((kk & 7) * 32 + (c & 31)) * 2; }
__device__ __forceinline__ int v_rd_base(int lane) { return ((lane & 3) << 3) | (((lane >> 2) & 3) << 6) | (((lane >> 4) & 1) << 5) | (((lane >> 5) & 1) << 8); }
constexpr int v_rd_off(int d0, int ks, int half) { return d0 * 512 + ks * 4096 + half * 2048; }
__device__ __forceinline__ int crow(int r, int hi) { return (r & 3) + 8 * (r >> 2) + 4 * hi; }
__device__ __forceinline__ unsigned cvtpk(float lo, float hi) {
    unsigned r; asm volatile("v_cvt_pk_bf16_f32 %0, %1, %2" : "=v"(r) : "v"(lo), "v"(hi)); return r;
}
__device__ __forceinline__ bf16x8 load8(const bf16* p) { return *reinterpret_cast<const bf16x8*>(p); }
__device__ __forceinline__ void mask_tile(f32x16& p0, f32x16& p1, int dq) {
    const float NEG = -__builtin_inff();
#pragma unroll
    for (int r = 0; r < 16; ++r) {
        const int c = (r & 3) + 8 * (r >> 2);
        if (dq - c < 0) p0[r] = NEG;
        if (dq - c - 32 < 0) p1[r] = NEG;
    }
}
__device__ __forceinline__ void partialSM(f32x16& p0, f32x16& p1, float& m_reg, float& mn, float& alpha) {
    float pmax = p0[0]; for (int r = 1; r < 16; ++r) pmax = fmaxf(pmax, p0[r]); for (int r = 0; r < 16; ++r) pmax = fmaxf(pmax, p1[r]);
    { auto rr = __builtin_amdgcn_permlane32_swap(__float_as_uint(pmax), __float_as_uint(pmax), false, false);
      pmax = fmaxf(__uint_as_float(rr[0]), __uint_as_float(rr[1])); }
    if (__builtin_expect(__all((pmax - m_reg) <= THRL), 1)) { mn = m_reg; alpha = 1.f; }
    else { mn = fmaxf(m_reg, pmax); alpha = __builtin_amdgcn_exp2f(m_reg - mn); m_reg = mn; }
    for (int r = 0; r < 16; ++r) p0[r] = p0[r] - mn; for (int r = 0; r < 16; ++r) p1[r] = p1[r] - mn;
    for (int r = 0; r < 16; ++r) p0[r] = __builtin_amdgcn_exp2f(p0[r]);
}
__device__ __forceinline__ void finishSM(f32x16& p0, f32x16& p1, float alpha, float& l_reg, bf16x8& pa0, bf16x8& pa1, bf16x8& pa2, bf16x8& pa3) {
    for (int r = 0; r < 16; ++r) p1[r] = __builtin_amdgcn_exp2f(p1[r]);
    float ps = 0; for (int r = 0; r < 16; ++r) ps += p0[r]; for (int r = 0; r < 16; ++r) ps += p1[r];
    { auto rr = __builtin_amdgcn_permlane32_swap(__float_as_uint(ps), __float_as_uint(ps), false, false);
      ps = __uint_as_float(rr[0]) + __uint_as_float(rr[1]); }
    l_reg = l_reg * alpha + ps;
#define PK4(P, B_, OUT) do { unsigned a0 = cvtpk(P[B_+0], P[B_+1]), a1 = cvtpk(P[B_+2], P[B_+3]);                          \
        unsigned b0 = cvtpk(P[B_+4], P[B_+5]), b1 = cvtpk(P[B_+6], P[B_+7]);                                             \
        auto r0 = __builtin_amdgcn_permlane32_swap(a0, b0, false, false); auto r1 = __builtin_amdgcn_permlane32_swap(a1, b1, false, false); \
        u32x4 w = {r0[0], r1[0], r0[1], r1[1]}; OUT = *reinterpret_cast<bf16x8*>(&w); } while (0)
    PK4(p0, 0, pa0); PK4(p0, 8, pa1); PK4(p1, 0, pa2); PK4(p1, 8, pa3);
#undef PK4
}
template <int KB>
__device__ __forceinline__ void qkt(f32x16& p0, f32x16& p1, const char* K_lds, const float* cbl, int r32, int hi, const bf16x8* qr) {
    const float* cb = cbl + KB * 64 + 4 * hi;
#pragma unroll
    for (int g = 0; g < 4; ++g) { const f32x4 a = *(const f32x4*)(cb + 8 * g), b = *(const f32x4*)(cb + 32 + 8 * g);
        p0[4 * g + 0] = a[0]; p0[4 * g + 1] = a[1]; p0[4 * g + 2] = a[2]; p0[4 * g + 3] = a[3];
        p1[4 * g + 0] = b[0]; p1[4 * g + 1] = b[1]; p1[4 * g + 2] = b[2]; p1[4 * g + 3] = b[3]; }
    const char* kb[4];
#pragma unroll
    for (int dd = 0; dd < 4; ++dd) kb[dd] = K_lds + KB * SHM_K + KSWZ(r32, (dd * 16 + hi * 8) * 2);
#pragma unroll
    for (int d0 = 0; d0 < 8; ++d0) { const char* a = kb[d0 & 3] + (d0 >> 2) * 128;
        bf16x8 b0 = *reinterpret_cast<const bf16x8*>(a);
        bf16x8 b1 = *reinterpret_cast<const bf16x8*>(a + 32 * 256);
        p0 = __builtin_amdgcn_mfma_f32_32x32x16_bf16(b0, qr[d0], p0, 0, 0, 0);
        p1 = __builtin_amdgcn_mfma_f32_32x32x16_bf16(b1, qr[d0], p1, 0, 0, 0); }
}
template <int VB>
__device__ __forceinline__ void pv_tile(f32x16* o, int vb0, bf16x8 pa0, bf16x8 pa1, bf16x8 pa2, bf16x8 pa3) {
#define TRRD(dst, off) asm volatile("ds_read_b64_tr_b16 %0, %1 offset:%2" : "=&v"(dst) : "v"(vb0), "i"(off) : "memory")
#define PV_D0(d0) do { s16x4 l0, l1, l2, l3, h0, h1, h2, h3; constexpr int b_ = VB * SHM_V + v_rd_off(d0, 0, 0);     \
        TRRD(l0, b_); TRRD(h0, b_ + 2048); TRRD(l1, b_ + 4096); TRRD(h1, b_ + 6144); TRRD(l2, b_ + 8192); TRRD(h2, b_ + 10240); TRRD(l3, b_ + 12288); TRRD(h3, b_ + 14336); \
        asm volatile("s_waitcnt lgkmcnt(0)" ::: "memory"); SBAR();                                                              \
        o[d0] = __builtin_amdgcn_mfma_f32_32x32x16_bf16(pa0, (bf16x8){l0[0], l0[1], l0[2], l0[3], h0[0], h0[1], h0[2], h0[3]}, o[d0], 0, 0, 0);   \
        o[d0] = __builtin_amdgcn_mfma_f32_32x32x16_bf16(pa1, (bf16x8){l1[0], l1[1], l1[2], l1[3], h1[0], h1[1], h1[2], h1[3]}, o[d0], 0, 0, 0);   \
        o[d0] = __builtin_amdgcn_mfma_f32_32x32x16_bf16(pa2, (bf16x8){l2[0], l2[1], l2[2], l2[3], h2[0], h2[1], h2[2], h2[3]}, o[d0], 0, 0, 0);   \
        o[d0] = __builtin_amdgcn_mfma_f32_32x32x16_bf16(pa3, (bf16x8){l3[0], l3[1], l3[2], l3[3], h3[0], h3[1], h3[2], h3[3]}, o[d0], 0, 0, 0); } while (0)
    PV_D0(0); PV_D0(1); PV_D0(2); PV_D0(3);
#undef PV_D0
#undef TRRD
}

struct BlockRef { const bf16* Q; const bf16* K; const bf16* V; bf16* O; const float* C; int P0, jlo; };
struct Seam { bf16x8 qr[8]; bf16x8 st_v0, st_v1, st_k0, st_k1; float st_c; };
#define ROW(p, k0, rr) ((p) + (size_t)((k0) + (rr)) * LDQ + sc)
#define VMW() asm volatile("s_waitcnt vmcnt(0)" ::: "memory")
#define VMWN(n) asm volatile("s_waitcnt vmcnt(%0)" :: "i"(n) : "memory")
#define SLOAD_H(Kp, Vp, Cp, cr, k0) do { const char* kb_ = (const char*)(Kp) + (size_t)(k0) * (LDQ * 2); const char* vb_ = (const char*)(Vp) + (size_t)(k0) * (LDQ * 2);     \
                         int u_ = threadIdx.x; asm volatile("" : "+v"(u_)); const unsigned voffA = (unsigned)((u_ >> 4) * LDQ + (u_ & 15) * 8) * 2u, voffB = voffA + 32u * LDQ * 2u; \
                         S.st_v0 = *(const bf16x8*)(vb_ + voffA); S.st_v1 = *(const bf16x8*)(vb_ + voffB);              \
                         S.st_k0 = *(const bf16x8*)(kb_ + voffA); S.st_k1 = *(const bf16x8*)(kb_ + voffB); S.st_c = (Cp)[(k0) + (u_ & 63)] - (cr); } while (0)
#define SWRITE_HK(bf) do { int t_ = threadIdx.x; asm volatile("" : "+v"(t_)); const int sr_ = t_ >> 4, sc_ = (t_ & 15) * 8, kws_ = KSWZ(sr_, sc_ * 2); \
        *(bf16x8*)(K_lds + (bf) * SHM_K + kws_) = S.st_k0; *(bf16x8*)(K_lds + (bf) * SHM_K + kws_ + 32 * 256) = S.st_k1; cbl[(bf) * 64 + (t_ & 63)] = S.st_c; } while (0)
#define SWRITE_HV(bf) do { int t_ = threadIdx.x; asm volatile("" : "+v"(t_)); const int sr_ = t_ >> 4, sc_ = (t_ & 15) * 8; \
        *(bf16x8*)(V_lds + (bf) * SHM_V + v_st(sr_, sc_)) = S.st_v0; *(bf16x8*)(V_lds + (bf) * SHM_V + v_st(32 + sr_, sc_)) = S.st_v1; } while (0)
#define SWRITE_H(bf) do { SWRITE_HV(bf); SWRITE_HK(bf); } while (0)
__device__ __forceinline__ void fox_prime(const BlockRef& cur, char* lds, Seam& S) {
    const int tid = threadIdx.x, wid = __builtin_amdgcn_readfirstlane(tid >> 6), lane = tid & 63, r32 = lane & 31, hi = lane >> 5;
    const int sr = tid >> 4, sc = (tid & 15) * 8, kws = KSWZ(sr, sc * 2); char* K_lds = lds + 2 * SHM_V; float* cbl = (float*)(lds + OFF_CB);
    const float cref = cur.C[cur.P0 + QB - 1];
    for (int d0 = 0; d0 < 8; ++d0) S.qr[d0] = load8(cur.Q + (size_t)(wid * QBLK + r32) * LDQ + d0 * 16 + hi * 8);
    SLOAD_H(cur.K, cur.V, cur.C, cref, cur.jlo * KVBLK); VMW(); SWRITE_HK(0);
    __syncthreads();
}
__device__ __forceinline__ void fox_block(const BlockRef& cur, const BlockRef& nxt, char* lds, Seam& S) {
    const int tid = threadIdx.x, wid = __builtin_amdgcn_readfirstlane(tid >> 6), lane = tid & 63, r32 = lane & 31, hi = lane >> 5;
    const int j_lo = cur.jlo, NT = (cur.P0 + QB - 1) / KVBLK + 1 - j_lo;
    const int qlo = cur.P0 + wid * QBLK, qm = qlo + r32 - 4 * hi;
    char* V_lds = lds; char* K_lds = lds + 2 * SHM_V; float* cbl = (float*)(lds + OFF_CB);
    float* ws = (float*)(lds + OFF_WS) + wid * 64; float* li_l = ws, * al_l = ws + 32;
    float l_reg = 0; f32x16 o[4] = {};
    const int sr = tid >> 4, sc = (tid & 15) * 8, vst0 = v_st(sr, sc), vst1 = v_st(32 + sr, sc), kws = KSWZ(sr, sc * 2);
    const int vb0 = (int)(uintptr_t)V_lds + v_rd_base(lane);
    const bf16* Kh = cur.K; const bf16* Vh = cur.V; const float* Ch = cur.C;
    const float cref = Ch[cur.P0 + QB - 1], crefn = nxt.C[nxt.P0 + QB - 1];
    float m_reg = Ch[qlo + r32] - cref - 4.0f;
#define RESC(a) do { if (__any((a) < 1.f)) { if (hi == 0) al_l[r32] = (a); asm volatile("s_waitcnt lgkmcnt(0)" ::: "memory");              \
                     for (int d_ = 0; d_ < 4; ++d_) for (int r = 0; r < 16; ++r) o[d_][r] *= al_l[crow(r, hi)]; } } while (0)
#define KBASE(t) ((j_lo + (t)) * KVBLK)
#define MASKT(P0_, P1_, t) do { const int kb_ = KBASE(t); if (kb_ + KVBLK - 1 > qlo) mask_tile(P0_, P1_, qm - kb_); } while (0)
    constexpr int NQL = 8;
#define SEAM_K0() do { VMWN(NQL); SWRITE_HK(0); SBAR(); } while (0)
    f32x16 pA0, pA1, pB0, pB1; float mnA, mnB, alA, alB; bf16x8 pa0, pa1, pa2, pa3;
    SWRITE_HV(0); SBAR();
    if (NT > 1) { SLOAD_H(Kh, Vh, Ch, cref, KBASE(1)); }
    SBAR(); qkt<0>(pA0, pA1, K_lds, cbl, r32, hi, S.qr);
    MASKT(pA0, pA1, 0); partialSM(pA0, pA1, m_reg, mnA, alA);
    if (NT > 1) { VMW(); SWRITE_H(1); }
    __syncthreads();
#define HALF_STEP(PX0, PX1, mnX, alX, PY0, PY1, alY, t, KB, VB, SB) do {                                                      \
        SBAR(); qkt<KB>(PX0, PX1, K_lds, cbl, r32, hi, S.qr);                                                                 \
        finishSM(PY0, PY1, alY, l_reg, pa0, pa1, pa2, pa3); SBAR();                                                           \
        if ((t) + 1 < NT) { SLOAD_H(Kh, Vh, Ch, cref, KBASE((t) + 1)); SBAR(); }                                              \
        pv_tile<VB>(o, vb0, pa0, pa1, pa2, pa3); MASKT(PX0, PX1, (t)); partialSM(PX0, PX1, m_reg, mnX, alX);                  \
        __syncthreads();                                                                                                      \
        if ((t) + 1 < NT) { VMW(); SWRITE_H(SB); }                                                                            \
        RESC(alX); __syncthreads(); } while (0)
    for (int t = 1; t + 1 < NT; t += 2) {
        HALF_STEP(pB0, pB1, mnB, alB, pA0, pA1, alA, t, 1, 0, 0);
        HALF_STEP(pA0, pA1, mnA, alA, pB0, pB1, alB, t + 1, 0, 1, 1);
    }
    const bool even = (NT & 1) == 0;
    if (even) { SBAR(); qkt<1>(pB0, pB1, K_lds, cbl, r32, hi, S.qr); SBAR(); }
    SLOAD_H(nxt.K, nxt.V, nxt.C, crefn, nxt.jlo * KVBLK); SBAR();
#pragma unroll
    for (int d0 = 0; d0 < 8; ++d0) S.qr[d0] = load8(nxt.Q + (size_t)(wid * QBLK + r32) * LDQ + d0 * 16 + hi * 8);
    SBAR();
    finishSM(pA0, pA1, alA, l_reg, pa0, pa1, pa2, pa3); SBAR();
    pv_tile<0>(o, vb0, pa0, pa1, pa2, pa3);
    if (even) { MASKT(pB0, pB1, NT - 1); partialSM(pB0, pB1, m_reg, mnB, alB); __syncthreads(); RESC(alB);
        finishSM(pB0, pB1, alB, l_reg, pa0, pa1, pa2, pa3); SBAR(); pv_tile<1>(o, vb0, pa0, pa1, pa2, pa3); }
    SBAR(); SEAM_K0();
    if (hi == 0) li_l[r32] = l_reg; asm volatile("s_waitcnt lgkmcnt(0)" ::: "memory");
    float rli[16];
#pragma unroll
    for (int r = 0; r < 16; ++r) rli[r] = __builtin_amdgcn_rcpf(li_l[crow(r, hi)]);
    bf16* Ow = cur.O + (size_t)(wid * QBLK) * LDQ;
#pragma unroll
    for (int r = 0; r < 16; ++r) { const int orow = crow(r, hi);
#pragma unroll
        for (int d0 = 0; d0 < 4; ++d0) { const float v = o[d0][r] * rli[r];
            const float vn = __shfl_xor(v, 1);
            if ((r32 & 1) == 0) *(unsigned*)(Ow + (size_t)orow * LDQ + d0 * 32 + r32) = cvtpk(v, vn); } }
    __syncthreads();
#undef RESC
#undef KBASE
#undef MASKT
#undef SEAM_K0
#undef HALF_STEP
}
#undef ROW
#undef VMW
#undef VMWN
#undef SLOAD_H
#undef SWRITE_HK
#undef SWRITE_HV
#undef SWRITE_H
#undef KSWZ
#undef SBAR

__device__ __forceinline__ int dq(char* lds, unsigned* ctr) {
    volatile __attribute__((address_space(3))) int* sq = (volatile __attribute__((address_space(3))) int*)(lds + LDS_BYTES);
    __syncthreads();
    if (threadIdx.x == 0) sq[0] = (int)__hip_atomic_fetch_add(ctr, 1u, __ATOMIC_RELAXED, __HIP_MEMORY_SCOPE_AGENT);
    __syncthreads();
    return __builtin_amdgcn_readfirstlane(sq[0]);
}
__device__ __forceinline__ BlockRef ref(int L, const bf16* Q, const bf16* K, const bf16* V, bf16* O, const float* CB, const int* jtab) {
    L &= 1023; const int bh = L & 63, qb = 15 - (L >> 6), b = bh >> 4, h = bh & 15; const size_t rowb = (size_t)b * SEQ;
    BlockRef r; r.Q = Q + (rowb + (size_t)qb * QB) * LDQ + h * D; r.O = O + (rowb + (size_t)qb * QB) * LDQ + h * D;
    r.K = K + rowb * LDQ + h * D; r.V = V + rowb * LDQ + h * D; r.C = CB + (size_t)bh * SEQ; r.P0 = qb * QB; r.jlo = __builtin_amdgcn_readfirstlane(jtab[L]); return r;
}
__device__ __forceinline__ void fox_jlo_item(char* lds, int L, const float* CB, const float* qn2, const float* kn2, int* jtab) {
    const int tid = threadIdx.x, lane = tid & 63, wid = tid >> 6;
    volatile __attribute__((address_space(3))) float* sf = (volatile __attribute__((address_space(3))) float*)(lds + 64);
    const int bh = L & 63, qb = 15 - (L >> 6), P0 = qb * QB;
    float qm = 0.f, km = 0.f;
    if (tid < QB) qm = qn2[(size_t)bh * SEQ + P0 + tid];
    for (int j = tid; j < P0 + QB; j += NW * 64) km = fmaxf(km, kn2[(size_t)bh * SEQ + j]);
#pragma unroll
    for (int o = 1; o < 64; o <<= 1) { qm = fmaxf(qm, __shfl_xor(qm, o)); km = fmaxf(km, __shfl_xor(km, o)); }
    __syncthreads();
    if (lane == 0) { sf[wid] = qm; sf[8 + wid] = km; }
    __syncthreads();
    if (tid < 64) {
        float q2 = 0.f, k2 = 0.f;
#pragma unroll
        for (int w = 0; w < 8; ++w) { q2 = fmaxf(q2, sf[w]); k2 = fmaxf(k2, sf[8 + w]); }
        const float thr = 2.04f * sqrtf(q2 * k2) + 40.f;
        const float* C = CB + (size_t)bh * SEQ; const int tmax = P0 / KVBLK;
        const bool keep = (lane >= tmax) || (C[64 * lane + 63] - C[P0] >= -thr);
        const unsigned long long m = __ballot(keep);
        if (tid == 0) jtab[L] = __builtin_ctzll(m);
    }
}
__device__ __forceinline__ void fox_phase(char* lds, const bf16* Q, const bf16* K, const bf16* V, bf16* O, const float* CB, unsigned* ctr, const int* jtab) {
    constexpr int total = NB * NH * 16 * (FOX_DOUBLE ? 2 : 1);
    int L = dq(lds, ctr); if (L >= total) return;
    int Ln = dq(lds, ctr);
    BlockRef cur = ref(L, Q, K, V, O, CB, jtab);
    Seam S;
    fox_prime(cur, lds, S);
    for (;;) {
        const bool last = Ln >= total;
        const BlockRef nxt = last ? cur : ref(Ln, Q, K, V, O, CB, jtab);
        fox_block(cur, nxt, lds, S);
        if (last) break;
        cur = nxt; L = Ln; Ln = dq(lds, ctr);
    }
}
}
namespace swa {
using bf16 = __hip_bfloat16;
typedef short bf16x8 __attribute__((ext_vector_type(8)));
typedef short s16x4 __attribute__((ext_vector_type(4)));
typedef float f32x16 __attribute__((ext_vector_type(16)));
typedef unsigned u32x4 __attribute__((ext_vector_type(4)));
constexpr int SEQ = 4096, LDQ = 2048, LDKV = 256, QT = 32, NKT = 5, KEYS = 160, VROW = 144, VBUF = KEYS * VROW, NUNITS = 4 * 4 * (SEQ / QT);
constexpr int OFF_WS = 2 * VBUF, LDS_BYTES = OFF_WS + 8 * 32 * 4;
__device__ __forceinline__ int crow(int r, int hi) { return (r & 3) + 8 * (r >> 2) + 4 * hi; }
__device__ __forceinline__ unsigned cvtpk(float lo, float hi) { unsigned r; asm volatile("v_cvt_pk_bf16_f32 %0, %1, %2" : "=v"(r) : "v"(lo), "v"(hi)); return r; }
struct UnitRef { int b, kvh, q0; };
__device__ __forceinline__ UnitRef decode(int u) { UnitRef r; r.b = u >> 9; r.kvh = (u >> 7) & 3; r.q0 = (u & 127) * QT; return r; }

__device__ __forceinline__ void swa_phase(char* lds, const bf16* Q, const bf16* Kc, const bf16* Vc, bf16* O, const float* sinks, int blk, int nblk) {
    const int tid = threadIdx.x, wid = __builtin_amdgcn_readfirstlane(tid >> 6), lane = tid & 63, r32 = lane & 31, hi = lane >> 5;
    float* wsf = (float*)(lds + OFF_WS) + wid * 32;
    int u = blk; if (u >= NUNITS) return;
    u32x4 st0, st1, st2;
#define V_LOAD(uu) do { const UnitRef R_ = decode(uu); const bf16* vb_ = Vc + (size_t)R_.b * SEQ * LDKV + R_.kvh * 64; \
        { const int c = tid, kk = c >> 3, ch = c & 7; int pos = R_.q0 - 128 + kk; pos = pos < 0 ? 0 : pos; st0 = *(const u32x4*)(vb_ + (size_t)pos * LDKV + ch * 8); } \
        { const int c = tid + 512, kk = c >> 3, ch = c & 7; int pos = R_.q0 - 128 + kk; pos = pos < 0 ? 0 : pos; st1 = *(const u32x4*)(vb_ + (size_t)pos * LDKV + ch * 8); } \
        if (tid < 256) { const int c = tid + 1024, kk = c >> 3, ch = c & 7; int pos = R_.q0 - 128 + kk; pos = pos < 0 ? 0 : pos; st2 = *(const u32x4*)(vb_ + (size_t)pos * LDKV + ch * 8); } } while (0)
#define V_WRITE(bufp) do { { const int c = tid; *(u32x4*)((bufp) + (c >> 3) * VROW + (c & 7) * 16) = st0; } \
        { const int c = tid + 512; *(u32x4*)((bufp) + (c >> 3) * VROW + (c & 7) * 16) = st1; } \
        if (tid < 256) { const int c = tid + 1024; *(u32x4*)((bufp) + (c >> 3) * VROW + (c & 7) * 16) = st2; } } while (0)
    V_LOAD(u); V_WRITE(lds);
    __syncthreads();
    int buf = 0;
    const int grp = lane >> 4, qq = (lane & 15) >> 2, pp = lane & 3;
    const int vrd = (8 * (grp >> 1) + qq) * VROW + (16 * (grp & 1) + 4 * pp) * 2;
    for (;;) {
        const int un = u + nblk; const bool has_next = un < NUNITS;
        if (has_next) V_LOAD(un);
        const UnitRef R = decode(u);
        const int h = R.kvh * 8 + wid; const size_t rowb = (size_t)R.b * SEQ;
        const float sink2 = sinks[h] * 1.4426950408889634f;
        bf16x8 qr[4];
        { const bf16* qp = Q + (rowb + R.q0 + r32) * LDQ + h * 64 + hi * 8;
#pragma unroll
          for (int d0 = 0; d0 < 4; ++d0) qr[d0] = *(const bf16x8*)(qp + d0 * 16); }
        f32x16 p[NKT];
#pragma unroll
        for (int j = 0; j < NKT; ++j) {
            int pos = R.q0 - 128 + 32 * j + r32; pos = pos < 0 ? 0 : pos;
            const bf16* kp = Kc + (rowb + pos) * LDKV + R.kvh * 64 + hi * 8;
            bf16x8 kf[4];
#pragma unroll
            for (int d0 = 0; d0 < 4; ++d0) kf[d0] = *(const bf16x8*)(kp + d0 * 16);
            f32x16 a = {};
#pragma unroll
            for (int d0 = 0; d0 < 4; ++d0) a = __builtin_amdgcn_mfma_f32_32x32x16_bf16(kf[d0], qr[d0], a, 0, 0, 0);
            p[j] = a;
        }
        { const int lo = (r32 + 1) > (128 - R.q0) ? (r32 + 1) : (128 - R.q0); const unsigned span = (unsigned)(r32 + 128 - lo); const float NEG = -__builtin_inff();
#pragma unroll
          for (int j = 0; j < NKT; ++j)
#pragma unroll
              for (int r = 0; r < 16; ++r) { const int kk = 32 * j + (r & 3) + 8 * (r >> 2) + 4 * hi; if ((unsigned)(kk - lo) > span) p[j][r] = NEG; } }
        float mx = sink2;
#pragma unroll
        for (int j = 0; j < NKT; ++j)
#pragma unroll
            for (int r = 0; r < 16; ++r) mx = fmaxf(mx, p[j][r]);
        { auto rr = __builtin_amdgcn_permlane32_swap(__float_as_uint(mx), __float_as_uint(mx), false, false); mx = fmaxf(__uint_as_float(rr[0]), __uint_as_float(rr[1])); }
        float ps = 0.f;
#pragma unroll
        for (int j = 0; j < NKT; ++j)
#pragma unroll
            for (int r = 0; r < 16; ++r) { const float e = __builtin_amdgcn_exp2f(p[j][r] - mx); p[j][r] = e; ps += e; }
        { auto rr = __builtin_amdgcn_permlane32_swap(__float_as_uint(ps), __float_as_uint(ps), false, false); ps = __uint_as_float(rr[0]) + __uint_as_float(rr[1]); }
        const float l = ps + __builtin_amdgcn_exp2f(sink2 - mx);
        bf16x8 pa[2 * NKT];
#define PK4(P, B_, OUT) do { unsigned a0 = cvtpk(P[B_+0], P[B_+1]), a1 = cvtpk(P[B_+2], P[B_+3]);                          \
        unsigned b0 = cvtpk(P[B_+4], P[B_+5]), b1 = cvtpk(P[B_+6], P[B_+7]);                                             \
        auto r0 = __builtin_amdgcn_permlane32_swap(a0, b0, false, false); auto r1 = __builtin_amdgcn_permlane32_swap(a1, b1, false, false); \
        u32x4 w = {r0[0], r1[0], r0[1], r1[1]}; OUT = *reinterpret_cast<bf16x8*>(&w); } while (0)
#pragma unroll
        for (int j = 0; j < NKT; ++j) { PK4(p[j], 0, pa[2 * j]); PK4(p[j], 8, pa[2 * j + 1]); }
#undef PK4
        f32x16 o[2] = {};
        const int vb = (int)(uintptr_t)(lds + buf * VBUF) + vrd;
#define TRRD(dst, off) asm volatile("ds_read_b64_tr_b16 %0, %1 offset:%2" : "=&v"(dst) : "v"(vb), "i"(off) : "memory")
#pragma unroll
        for (int g = 0; g < 2 * NKT; ++g) {
            s16x4 l0, h0, l1, h1;
            TRRD(l0, g * 16 * VROW); TRRD(h0, g * 16 * VROW + 4 * VROW); TRRD(l1, g * 16 * VROW + 64); TRRD(h1, g * 16 * VROW + 4 * VROW + 64);
            asm volatile("s_waitcnt lgkmcnt(0)" ::: "memory"); __builtin_amdgcn_sched_barrier(0);
            o[0] = __builtin_amdgcn_mfma_f32_32x32x16_bf16(pa[g], (bf16x8){l0[0], l0[1], l0[2], l0[3], h0[0], h0[1], h0[2], h0[3]}, o[0], 0, 0, 0);
            o[1] = __builtin_amdgcn_mfma_f32_32x32x16_bf16(pa[g], (bf16x8){l1[0], l1[1], l1[2], l1[3], h1[0], h1[1], h1[2], h1[3]}, o[1], 0, 0, 0);
        }
#undef TRRD
        if (hi == 0) wsf[r32] = l;
        asm volatile("s_waitcnt lgkmcnt(0)" ::: "memory");
        bf16* Ow = O + (rowb + R.q0) * LDQ + h * 64;
#pragma unroll
        for (int r = 0; r < 16; ++r) { const int orow = crow(r, hi); const float rl = __builtin_amdgcn_rcpf(wsf[orow]);
#pragma unroll
            for (int d0 = 0; d0 < 2; ++d0) { const float v = o[d0][r] * rl; const float vn = __shfl_xor(v, 1);
                if ((r32 & 1) == 0) *(unsigned*)(Ow + (size_t)orow * LDQ + d0 * 32 + r32) = cvtpk(v, vn); } }
        if (has_next) V_WRITE(lds + (buf ^ 1) * VBUF);
        __syncthreads();
        if (!has_next) break;
        u = un; buf ^= 1;
    }
#undef V_LOAD
#undef V_WRITE
}
}
constexpr int NWAVES = 8;
#ifndef MK_PER_PHASE
#define MK_PER_PHASE 0
#endif
constexpr int N_PHASES = 18;
#ifndef FP8_MASK
#define FP8_MASK 3
#endif
constexpr float W8SCALE = 64.f;

constexpr int SEQ = 4096, NBATCH = 4, T = NBATCH * SEQ, D = 2048, NEXP = 64, TOPK = 8, EH = 512;
constexpr int NQKV_A = 3 * D, LDWIN = 3 * D + 16, NQKV_B = D + 512;
constexpr float ALPHA = 1.4142135623730951f, LN_EPS = 1e-5f;
constexpr float QSCALE_A = 0.08838834764831845f * 1.4426950408889634f;
constexpr float QSCALE_B = 0.125f * 1.4426950408889634f;
constexpr int MAXTILES = 640, MAXROWS = MAXTILES * 256;

constexpr size_t MiB = 1u << 20;
constexpr size_t WS_CTL = 0, CTL_ZERO_BYTES = 1 * MiB;
constexpr size_t WS_ROPE = 1 * MiB;
constexpr size_t WS_LOGF = 2 * MiB;
constexpr size_t WS_CB = 3 * MiB;
constexpr size_t WS_EIDX = 4 * MiB, WS_WTS = WS_EIDX + 512 * 1024, WS_SLOT = 5 * MiB, WS_TOK = WS_SLOT + 512 * 1024, WS_GATE = WS_TOK + 640 * 1024, WS_TILE = 7 * MiB;
constexpr size_t WS_NRM = 1360 * MiB;
constexpr size_t WS_GHIST = 8 * MiB;
constexpr size_t WS_GT = 9 * MiB;
constexpr size_t WS_WQKV_A = 12 * MiB, WS_WO_A = 36 * MiB, WS_WQKV_B = 44 * MiB, WS_WO_B = 54 * MiB;
constexpr size_t WS_WGU = 64 * MiB, WGU_L = 260 * MiB, WS_WD = 584 * MiB, WD_L = 130 * MiB;
constexpr size_t WS_XB = 848 * MiB, WS_QB = 912 * MiB, WS_KB = 976 * MiB, WS_VB = 1040 * MiB, WS_AO = 1104 * MiB;
constexpr size_t WS_Y1 = 1168 * MiB, WS_X1 = 1296 * MiB, WS_X1B = 1424 * MiB, WS_ACT = 1488 * MiB, WS_YP = 1648 * MiB, WS_X2 = 2288 * MiB, WS_END = 2416 * MiB;
static_assert(WS_GT + 2 * 64 * 2048 * 4 + 4096 <= WS_WQKV_A && WS_ACT + (size_t)MAXROWS * 512 * 2 <= WS_YP && WS_YP + (size_t)MAXROWS * 2048 * 2 <= WS_X2, "ws map");
constexpr int CW_TMO = 0;
constexpr int CW_CNT = 1024;
constexpr int CW_CUR = 2048;
constexpr int CW_CVTQ = 3648;
constexpr int CW_FOXQ = 3584;
constexpr int CW_NT = 3072;
constexpr int CW_BAR = 4096;

constexpr int RING_OFF = 0, RING_BYTES = 131072;
constexpr int LDSCTL_OFF = RING_BYTES, MISC_OFF = LDSCTL_OFF + 320;
constexpr int LDS_BYTES = 147456;
static_assert(MISC_OFF + 128 <= LDS_BYTES && fox::LDS_BYTES + 256 <= RING_BYTES && swa::LDS_BYTES <= RING_BYTES, "LDS map");

#define GAS __attribute__((address_space(1)))
#define LAS __attribute__((address_space(3)))
typedef unsigned short bf16;
typedef unsigned v4u __attribute__((ext_vector_type(4)));
typedef unsigned v2u __attribute__((ext_vector_type(2)));
typedef float f32x4 __attribute__((ext_vector_type(4)));
typedef GAS unsigned gu32;
#define RLX_AGENT __ATOMIC_RELAXED, __HIP_MEMORY_SCOPE_AGENT
#define LDS_WAIT() asm volatile("s_waitcnt lgkmcnt(0)" ::: "memory")
#define VM_WAIT() asm volatile("s_waitcnt vmcnt(0)" ::: "memory")
__device__ __forceinline__ unsigned f2bf(float f) { unsigned u = __builtin_bit_cast(unsigned, f); return (u + 0x7fffu + ((u >> 16) & 1u)) >> 16; }
__device__ __forceinline__ unsigned pk2(float lo, float hi) { return f2bf(lo) | (f2bf(hi) << 16); }
__device__ __forceinline__ float bf_lo(unsigned w) { return __builtin_bit_cast(float, w << 16); }
__device__ __forceinline__ float bf_hi(unsigned w) { return __builtin_bit_cast(float, w & 0xffff0000u); }

#define XB_TMO      128
#define XB_XCNT(j)  (256  + 64 * (j))
#define XB_XSUB(j)  (1280 + 64 * (j))
#define XB_XGEN(j)  (2304 + 64 * (j))
#define XB_TOP      3328
#define XB_TOPGEN   3392
#define XCD_BAR_WORDS 3456
#define XB_SPIN_CAP (1u << 18)

__device__ __forceinline__ unsigned xb_ld(unsigned* p)              { return __hip_atomic_load(p, __ATOMIC_RELAXED, __HIP_MEMORY_SCOPE_AGENT); }
__device__ __forceinline__ unsigned xb_add(unsigned* p, unsigned v) { return __hip_atomic_fetch_add(p, v, __ATOMIC_RELAXED, __HIP_MEMORY_SCOPE_AGENT); }
__device__ __forceinline__ unsigned xb_xcc_id() { return (unsigned)__builtin_amdgcn_s_getreg((3 << 11) | 20) & 0xFu; }
#define XB_SPIN(cond, bar) do { unsigned _sp = 0; while (cond) { __builtin_amdgcn_s_sleep(1); \
    if ((++_sp & 255u) == 0u) { if (xb_ld(&(bar)[XB_TMO])) break; if (_sp > XB_SPIN_CAP) { atomicAdd(&(bar)[XB_TMO], 1u); break; } } } } while (0)

struct XcdBarrier {
    unsigned* bar; unsigned x;
    volatile LAS unsigned* st;
};
__device__ __forceinline__ XcdBarrier xcd_barrier_post(unsigned* bar, volatile LAS unsigned* st) {
    XcdBarrier b; b.bar = bar; b.x = xb_xcc_id(); b.st = st;
    if (threadIdx.x == 0) (void)xb_add(&bar[XB_XCNT(b.x)], 1u);
    return b;
}
__device__ __forceinline__ void xcd_barrier_complete(unsigned* bar, unsigned x, unsigned& nloc, unsigned& nx) {
    const unsigned G = gridDim.x * gridDim.y * gridDim.z;
    unsigned sum, cnt, mine, sp = 0u;
    for (;;) {
        sum = 0u; cnt = 0u; mine = 0u;
#pragma unroll
        for (unsigned j = 0; j < 16; ++j) { const unsigned c = xb_ld(&bar[XB_XCNT(j)]); sum += c; cnt += (c > 0u) ? 1u : 0u; mine = (j == x) ? c : mine; }
        if (sum == G) break;
        __builtin_amdgcn_s_sleep(1);
        if ((++sp & 255u) == 0u) { if (xb_ld(&bar[XB_TMO])) break; if (sp > XB_SPIN_CAP) { atomicAdd(&bar[XB_TMO], 1u); break; } }
    }
    nloc = mine > 0u ? mine : 1u; nx = cnt > 0u ? cnt : 1u;
}
__device__ __forceinline__ void xcd_barrier(const XcdBarrier& b) {
    asm volatile("s_waitcnt vmcnt(0)" ::: "memory");
    __syncthreads();
    if (threadIdx.x == 0) {
        unsigned* bar = b.bar;
        __builtin_amdgcn_s_waitcnt(0);
        unsigned nloc = b.st[0], nx = b.st[1];
        if (nloc == 0u) { xcd_barrier_complete(bar, b.x, nloc, nx); b.st[0] = nloc; b.st[1] = nx; }
        const unsigned old = xb_add(&bar[XB_XSUB(b.x)], 1u);
        const unsigned gen = old / nloc;
        if (old + 1u == (gen + 1u) * nloc) {
            __builtin_amdgcn_fence(__ATOMIC_RELEASE, "agent");
            asm volatile("s_waitcnt vmcnt(0)" ::: "memory");
            const unsigned og = xb_add(&bar[XB_TOP], 1u);
            const unsigned tg = og / nx;
            if (og + 1u == (tg + 1u) * nx) xb_add(&bar[XB_TOPGEN], 1u);
            else XB_SPIN(xb_ld(&bar[XB_TOPGEN]) == tg, bar);
            __builtin_amdgcn_fence(__ATOMIC_ACQUIRE, "agent");
            xb_add(&bar[XB_XGEN(b.x)], 1u);
            asm volatile("s_waitcnt vmcnt(0)" ::: "memory");
        } else {
            XB_SPIN(xb_ld(&bar[XB_XGEN(b.x)]) == gen, bar);
            __builtin_amdgcn_fence(__ATOMIC_ACQUIRE, "agent");
            asm volatile("s_waitcnt vmcnt(0)" ::: "memory");
        }
    }
    __syncthreads();
}

struct Frame {
    LAS unsigned char* lds;
    unsigned char* ws;
    gu32* ctl;
    int tid, lane, wave;
    int vcu, G;
    const float* in[18]; float* out;
};
__device__ __forceinline__ float wave_sum(float v) {
#pragma unroll
    for (int o = 1; o < 64; o <<= 1) v += __shfl_xor(v, o);
    return v;
}

__device__ __forceinline__ int map_rope(int n) { const int t = n >> 8, w = n & 127, bj = (n >> 7) & 1; return 256 * t + 64 * (w >> 5) + 32 * bj + (w & 31); }
__device__ __forceinline__ int map_gu(int n) { const int t = n >> 8, w = n & 127, bj = (n >> 7) & 1; return 512 * bj + 128 * t + w; }

constexpr int CVT_I_QKVA = 16 * (NQKV_A / 32), CVT_I_WO = 16 * (D / 32), CVT_I_QKVB = 16 * (NQKV_B / 32), CVT_I_GU1 = 16 * 32, CVT_I_D1 = 4 * 64;
constexpr int CVT_O_WOA = CVT_I_QKVA, CVT_O_QKVB = CVT_O_WOA + CVT_I_WO, CVT_O_WOB = CVT_O_QKVB + CVT_I_QKVB, CVT_O_GU = CVT_O_WOB + CVT_I_WO, CVT_O_D = CVT_O_GU + 2 * 65 * CVT_I_GU1, CVT_NSUPER = CVT_O_D + 2 * 65 * CVT_I_D1;
constexpr int CVT_CH = 16, CVT_NCHUNK = (CVT_NSUPER - CVT_O_GU) / CVT_CH;
static_assert((CVT_NSUPER - CVT_O_GU) % CVT_CH == 0, "chunking");
template <bool DYN>
__device__ __forceinline__ void convert_weights(Frame& F, LAS float* scr, int limit = CVT_NCHUNK) {
    const int gw = F.vcu * NWAVES + F.wave, NGW = F.G * NWAVES, lane = F.lane;
    unsigned char* ws = F.ws;
    constexpr int O_WOA = CVT_O_WOA, O_QKVB = CVT_O_QKVB, O_WOB = CVT_O_WOB, O_GU = CVT_O_GU, O_D = CVT_O_D, I_GU1 = CVT_I_GU1, I_D1 = CVT_I_D1;
    constexpr int END = 0x7fffffff;
    struct TrD { const float* W; unsigned char* WT; int ldw, Kb, f8; };
    auto decode = [&](int step) -> TrD { TrD d; const int it = step >> 1, hf = step & 1;
        if (it < O_WOA) { const int nb = it % (NQKV_A / 32), kb = 2 * (it / (NQKV_A / 32)) + hf; d.W = F.in[1] + (size_t)(64 * kb) * LDWIN + 32 * nb; d.ldw = LDWIN; d.Kb = D * 2; d.f8 = 0; d.WT = ws + WS_WQKV_A + (size_t)(32 * nb) * (D * 2) + 128 * kb; }
        else if (it < O_QKVB) { const int r = it - O_WOA, nb = r % 64, kb = 2 * (r / 64) + hf; d.W = F.in[3] + (size_t)(64 * kb) * D + 32 * nb; d.ldw = D; d.Kb = D * 2; d.f8 = 0; d.WT = ws + WS_WO_A + (size_t)(32 * nb) * (D * 2) + 128 * kb; }
        else if (it < O_WOB) { const int r = it - O_QKVB, nb = r % (NQKV_B / 32), kb = 2 * (r / (NQKV_B / 32)) + hf, n = 32 * nb; d.Kb = D * 2; d.f8 = 0; d.WT = ws + WS_WQKV_B + (size_t)n * (D * 2) + 128 * kb;
            if (n < D) { d.W = F.in[5] + (size_t)(64 * kb) * D + map_rope(n); d.ldw = D; }
            else if (n < D + 256) { d.W = F.in[4] + (size_t)(64 * kb) * 512 + map_rope(n - D); d.ldw = 512; }
            else { d.W = F.in[4] + (size_t)(64 * kb) * 512 + (n - D); d.ldw = 512; } }
        else if (it < O_GU) { const int r = it - O_WOB, nb = r % 64, kb = 2 * (r / 64) + hf; d.W = F.in[7] + (size_t)(64 * kb) * D + 32 * nb; d.ldw = D; d.Kb = D * 2; d.f8 = 0; d.WT = ws + WS_WO_B + (size_t)(32 * nb) * (D * 2) + 128 * kb; }
        else if (it < O_D) { const int r = it - O_GU, le = r / I_GU1, q = r % I_GU1, l = le / 65, e = le % 65, nb = q % 32, kb = 2 * (q / 32) + hf;
            const float* src = e < 64 ? F.in[10] + ((size_t)(l * 64 + e)) * D * 1024 : F.in[12] + (size_t)l * D * 1024;
            d.W = src + (size_t)(64 * kb) * 1024 + map_gu(32 * nb); d.ldw = 1024; d.f8 = (FP8_MASK >> l) & 1; d.Kb = d.f8 ? D : D * 2;
            d.WT = ws + WS_WGU + (size_t)l * WGU_L + ((size_t)e * 1024 + 32 * nb) * d.Kb + (d.f8 ? 64 : 128) * kb; }
        else { const int r = it - O_D, le = r / I_D1, q = r % I_D1, l = le / 65, e = le % 65, nb = q % 64, kb = 2 * (q / 64) + hf;
            const float* src = e < 64 ? F.in[11] + ((size_t)(l * 64 + e)) * EH * D : F.in[13] + (size_t)l * EH * D;
            d.W = src + (size_t)(64 * kb) * D + 32 * nb; d.ldw = D; d.f8 = (FP8_MASK >> l) & 1; d.Kb = d.f8 ? EH : EH * 2;
            d.WT = ws + WS_WD + (size_t)l * WD_L + ((size_t)e * D + 32 * nb) * d.Kb + (d.f8 ? 64 : 128) * kb; }
        return d; };
    gu32* cq = F.ctl + CW_CVTQ;
    auto pull = [&]() -> int { unsigned v = 0u; if (lane == 0) v = __hip_atomic_fetch_add(cq, 1u, RLX_AGENT); return __builtin_amdgcn_readfirstlane((int)v); };
    int chunk_end = 0, nextchunk = 0; bool no_more = false;
    int it;
    if constexpr (DYN) { const int c0 = pull(); no_more = c0 >= limit; nextchunk = no_more ? CVT_NCHUNK : pull(); no_more = no_more || nextchunk >= limit;
        if (c0 >= CVT_NCHUNK) it = END; else { it = 2 * (O_GU + c0 * CVT_CH); chunk_end = O_GU + (c0 + 1) * CVT_CH; } }
    else it = gw < O_GU ? 2 * gw : END;
    auto advance = [&](int cur) -> int {
        if (!(cur & 1)) return cur + 1;
        if constexpr (DYN) { const int s = (cur >> 1) + 1; if (s < chunk_end) return 2 * s;
            const int c = nextchunk; if (c >= CVT_NCHUNK) return END; nextchunk = no_more ? CVT_NCHUNK : pull(); no_more = no_more || nextchunk >= limit; chunk_end = O_GU + (c + 1) * CVT_CH; return 2 * (O_GU + c * CVT_CH); }
        else { const int s = (cur >> 1) + NGW; return s < O_GU ? 2 * s : END; } };
    const int r8 = lane >> 3, c4 = (lane & 7) * 4;
    f32x4 va[8], vb[8];
    TrD dc{};
    if (it != END) { dc = decode(it);
#pragma unroll
        for (int i = 0; i < 8; ++i) va[i] = *(const GAS f32x4*)(dc.W + (size_t)(8 * i + r8) * dc.ldw + c4); }
    while (it != END) {
        const int itn = advance(it); TrD dn = dc;
        if (itn != END) { dn = decode(itn);
#pragma unroll
            for (int i = 0; i < 8; ++i) vb[i] = *(const GAS f32x4*)(dn.W + (size_t)(8 * i + r8) * dn.ldw + c4); }
#pragma unroll
        for (int i = 0; i < 8; ++i) { LAS float* p = scr + (8 * i + r8) * 33 + c4; p[0] = va[i].x; p[1] = va[i].y; p[2] = va[i].z; p[3] = va[i].w; }
        LDS_WAIT(); asm volatile("" ::: "memory");
        if (dc.f8) { const int c = lane & 3;
#pragma unroll
            for (int h = 0; h < 2; ++h) { const int n = (lane >> 2) + 16 * h; const LAS float* s = scr + (16 * c) * 33 + n;
                v4u o;
                o.x = pg8::pk4_fp8(s[0 * 33] * W8SCALE, s[1 * 33] * W8SCALE, s[2 * 33] * W8SCALE, s[3 * 33] * W8SCALE);
                o.y = pg8::pk4_fp8(s[4 * 33] * W8SCALE, s[5 * 33] * W8SCALE, s[6 * 33] * W8SCALE, s[7 * 33] * W8SCALE);
                o.z = pg8::pk4_fp8(s[8 * 33] * W8SCALE, s[9 * 33] * W8SCALE, s[10 * 33] * W8SCALE, s[11 * 33] * W8SCALE);
                o.w = pg8::pk4_fp8(s[12 * 33] * W8SCALE, s[13 * 33] * W8SCALE, s[14 * 33] * W8SCALE, s[15 * 33] * W8SCALE);
                *(GAS v4u*)(dc.WT + (size_t)n * dc.Kb + 16 * c) = o; } }
        else { const int c = lane & 7;
#pragma unroll
            for (int j = 0; j < 4; ++j) { const int n = (lane >> 3) + 8 * j; const LAS float* s = scr + (8 * c) * 33 + n;
                v4u o; o.x = pk2(s[0 * 33], s[1 * 33]); o.y = pk2(s[2 * 33], s[3 * 33]); o.z = pk2(s[4 * 33], s[5 * 33]); o.w = pk2(s[6 * 33], s[7 * 33]);
                *(GAS v4u*)(dc.WT + (size_t)n * dc.Kb + 16 * c) = o; } }
        LDS_WAIT(); asm volatile("" ::: "memory");
#pragma unroll
        for (int i = 0; i < 8; ++i) va[i] = vb[i];
        dc = dn; it = itn;
    }
}

__device__ __forceinline__ void p0_prologue(Frame& F) {
    LAS float* scr = (LAS float*)(F.lds + RING_OFF + F.wave * 16384);
    const int gw = F.vcu * NWAVES + F.wave, NGW = F.G * NWAVES, lane = F.lane;
    unsigned char* ws = F.ws;
    {
        const float* x = F.in[0]; const float* win = F.in[1]; const float* bfv = F.in[2];
        bf16* xb = (bf16*)(ws + WS_XB); float* logf = (float*)(ws + WS_LOGF);
        const int r = lane & 15, kq = lane >> 4;
        for (int grp = gw; grp < T / 16; grp += NGW) {
            const float* xr = x + (size_t)(grp * 16 + r) * D + 4 * kq; bf16* xo = xb + (size_t)(grp * 16 + r) * D + 4 * kq;
            const float* wf = win + NQKV_A + r + (size_t)(4 * kq) * LDWIN;
            f32x4 acc = {0.f, 0.f, 0.f, 0.f};
#pragma unroll 4
            for (int j = 0; j < D / 16; ++j) {
                const f32x4 xv = *(const f32x4*)(xr + 16 * j);
                const float* wp = wf + (size_t)(16 * j) * LDWIN;
                const float w0 = wp[0], w1 = wp[LDWIN], w2 = wp[2 * LDWIN], w3 = wp[3 * LDWIN];
                acc = __builtin_amdgcn_mfma_f32_16x16x4f32(xv[0], w0, acc, 0, 0, 0);
                acc = __builtin_amdgcn_mfma_f32_16x16x4f32(xv[1], w1, acc, 0, 0, 0);
                acc = __builtin_amdgcn_mfma_f32_16x16x4f32(xv[2], w2, acc, 0, 0, 0);
                acc = __builtin_amdgcn_mfma_f32_16x16x4f32(xv[3], w3, acc, 0, 0, 0);
                v2u o; o.x = pk2(xv[0], xv[1]); o.y = pk2(xv[2], xv[3]); *(GAS v2u*)(xo + 16 * j) = o;
            }
            const float bb = bfv[r];
#pragma unroll
            for (int i = 0; i < 4; ++i) { const float z = acc[i] + bb; const float ls = -(fmaxf(-z, 0.f) + log1pf(expf(-fabsf(z))));
                logf[(size_t)(grp * 16 + 4 * kq + i) * 16 + r] = ls; }
        }
    }
    {
        { float* nz = (float*)(ws + WS_NRM); for (int i = gw * 64 + lane; i < 2 * 64 * SEQ; i += NGW * 64) nz[i] = 0.f; }
        float* cs = (float*)(ws + WS_ROPE); float* sn = cs + SEQ * 32;
        const int gt = gw * 64 + lane, NGT = NGW * 64;
        for (int i = gt; i < SEQ * 32; i += NGT) { const int pos = i >> 5, d = i & 31;
            const double inv = exp(-(double)d * (9.210340371976184 / 32.0)); const double ang = (double)pos * inv;
            cs[i] = (float)cos(ang); sn[i] = (float)sin(ang); }
        float* GT = (float*)(ws + WS_GT); float* c1 = GT + 2 * 64 * 2048; float* c0 = c1 + 128;
        for (int it = gw; it < 128; it += NGW) { const int l = it >> 6, e = it & 63;
            const float* rw = F.in[8] + (size_t)l * D * 64 + e; const float* g = F.in[14] + l * D; const float* b = F.in[15] + l * D;
            float s1 = 0.f, s0 = 0.f;
            for (int k = lane; k < D; k += 64) { const float w = rw[(size_t)k * 64]; const float gv = g[k] * w; GT[(size_t)it * D + k] = gv; s1 += gv; s0 += b[k] * w; }
            s1 = wave_sum(s1); s0 = wave_sum(s0);
            if (lane == 0) { c1[it] = s1; c0[it] = s0; } }
    }
    convert_weights<false>(F, scr);
}

__device__ __forceinline__ void p1_scan(Frame& F) {
    LAS double* sh = (LAS double*)(F.lds + RING_OFF);
    const float* logf = (const float*)(F.ws + WS_LOGF); float* cb = (float*)(F.ws + WS_CB);
    for (int ch = blockIdx.x; ch < 64; ch += F.G) {
        const int b = ch >> 4, h = ch & 15; const int s0 = F.tid * 8;
        double v[8]; double run = 0.0;
#pragma unroll
        for (int i = 0; i < 8; ++i) { run += (double)logf[((size_t)b * SEQ + s0 + i) * 16 + h]; v[i] = run; }
        double inc = run;
#pragma unroll
        for (int o = 1; o < 64; o <<= 1) { const double n = __shfl_up(inc, o); if (F.lane >= o) inc += n; }
        if (F.lane == 63) sh[F.wave] = inc;
        __syncthreads();
        double base = 0.0;
        for (int w = 0; w < F.wave; ++w) base += sh[w];
        base += inc - run;
#pragma unroll
        for (int i = 0; i < 8; ++i) cb[(size_t)ch * SEQ + s0 + i] = (float)(-(base + v[i]) * 1.4426950408889634);
        __syncthreads();
    }
}

template <bool XF32>
__device__ __forceinline__ void ln_router_phase(Frame& F, int l, const void* xres, const bf16* hmix, bf16* x1b, unsigned char* x1q) {
    const int lane = F.lane;
    auto ldy = [&](size_t elem) -> f32x4 {
        const v2u hw_ = *(const GAS v2u*)(hmix + elem); f32x4 xv;
        if constexpr (XF32) xv = *(const GAS f32x4*)((const float*)xres + elem);
        else { const v2u xw = *(const GAS v2u*)((const bf16*)xres + elem); xv = (f32x4){bf_lo(xw.x), bf_hi(xw.x), bf_lo(xw.y), bf_hi(xw.y)}; }
        return xv * ALPHA + (f32x4){bf_lo(hw_.x), bf_hi(hw_.x), bf_lo(hw_.y), bf_hi(hw_.y)}; };
    LAS float* wsc = (LAS float*)(F.lds + RING_OFF + F.wave * 8704);
    LAS float* sc = wsc; LAS float* chs = wsc + 16 * 65; LAS unsigned* hw = (LAS unsigned*)(wsc + 2 * 16 * 65);
    LAS float* smean = (LAS float*)(F.lds + RING_OFF + 8 * 8704); LAS float* srstd = smean + 64;
    const float* g = F.in[14] + l * D; const float* bta = F.in[15] + l * D;
    const float* GT = (const float*)(F.ws + WS_GT) + (size_t)l * 64 * D; const float* c1 = (const float*)(F.ws + WS_GT) + 2 * 64 * D + l * 64; const float* c0 = c1 + 128;
    const float* rbias = F.in[9] + l * 64;
    int* eidx = (int*)(F.ws + WS_EIDX); float* wts = (float*)(F.ws + WS_WTS); unsigned* ghist = (unsigned*)(F.ws + WS_GHIST);
    for (int chunk = F.vcu; chunk < T / 64; chunk += F.G) {
        for (int rr = 0; rr < 8; rr += 2) {
            const int lr = F.wave * 8 + rr; const size_t row = (size_t)chunk * 64 + lr;
            f32x4 v[2][8]; float s[2] = {0.f, 0.f};
#pragma unroll
            for (int q = 0; q < 2; ++q)
#pragma unroll
                for (int j = 0; j < 8; ++j) v[q][j] = ldy((row + q) * D + 4 * lane + 256 * j);
#pragma unroll
            for (int q = 0; q < 2; ++q)
#pragma unroll
                for (int j = 0; j < 8; ++j) s[q] += (v[q][j].x + v[q][j].y) + (v[q][j].z + v[q][j].w);
            float mean[2], rstd[2], s2[2] = {0.f, 0.f};
#pragma unroll
            for (int o = 1; o < 64; o <<= 1) { s[0] += __shfl_xor(s[0], o); s[1] += __shfl_xor(s[1], o); }
#pragma unroll
            for (int q = 0; q < 2; ++q) { mean[q] = s[q] * (1.f / D);
#pragma unroll
                for (int j = 0; j < 8; ++j) { v[q][j] = v[q][j] - mean[q]; s2[q] += (v[q][j].x * v[q][j].x + v[q][j].y * v[q][j].y) + (v[q][j].z * v[q][j].z + v[q][j].w * v[q][j].w); } }
#pragma unroll
            for (int o = 1; o < 64; o <<= 1) { s2[0] += __shfl_xor(s2[0], o); s2[1] += __shfl_xor(s2[1], o); }
#pragma unroll
            for (int q = 0; q < 2; ++q) { rstd[q] = 1.f / sqrtf(s2[q] * (1.f / D) + LN_EPS); if (lane == 0) { smean[lr + q] = mean[q]; srstd[lr + q] = rstd[q]; } }
#pragma unroll
            for (int j = 0; j < 8; ++j) { const f32x4 gv = *((const GAS f32x4*)g + lane + 64 * j), bv = *((const GAS f32x4*)bta + lane + 64 * j);
#pragma unroll
                for (int q = 0; q < 2; ++q) { const f32x4 o = v[q][j] * rstd[q] * gv + bv; v2u w; w.x = pk2(o.x, o.y); w.y = pk2(o.z, o.w);
                    ((GAS v2u*)(x1b + (row + q) * D) + lane)[64 * j] = w;
                    if (x1q) ((GAS unsigned*)(x1q + (row + q) * D) + lane)[64 * j] = pg8::pk4_fp8(o.x, o.y, o.z, o.w); } }
        }
        LDS_WAIT();
        __syncthreads();
        {
            const int grp = chunk * 4 + (F.wave & 3), kh = F.wave >> 2;
            const int r = lane & 15, kq = lane >> 4;
            const size_t yo = ((size_t)grp * 16 + r) * D + 4 * kq + kh * (D / 2); const float* gt = GT + (size_t)r * D + 4 * kq + kh * (D / 2);
            f32x4 acc[4];
#pragma unroll
            for (int nt = 0; nt < 4; ++nt) acc[nt] = (f32x4){0.f, 0.f, 0.f, 0.f};
#pragma unroll 4
            for (int j = 0; j < D / 32; ++j) {
                const f32x4 yv = ldy(yo + 16 * j);
#pragma unroll
                for (int nt = 0; nt < 4; ++nt) { const f32x4 wv = *(const f32x4*)(gt + (size_t)(16 * nt) * D + 16 * j);
                    acc[nt] = __builtin_amdgcn_mfma_f32_16x16x4f32(yv[0], wv[0], acc[nt], 0, 0, 0);
                    acc[nt] = __builtin_amdgcn_mfma_f32_16x16x4f32(yv[1], wv[1], acc[nt], 0, 0, 0);
                    acc[nt] = __builtin_amdgcn_mfma_f32_16x16x4f32(yv[2], wv[2], acc[nt], 0, 0, 0);
                    acc[nt] = __builtin_amdgcn_mfma_f32_16x16x4f32(yv[3], wv[3], acc[nt], 0, 0, 0); }
            }
            LAS f32x4* px = (LAS f32x4*)(F.lds + RING_OFF + 8 * 8704 + 1024) + (F.wave & 3) * 256;
            if (kh) {
#pragma unroll
                for (int nt = 0; nt < 4; ++nt) px[nt * 64 + lane] = acc[nt]; }
            LDS_WAIT();
            __syncthreads();
            if (!kh) {
#pragma unroll
            for (int nt = 0; nt < 4; ++nt) acc[nt] = acc[nt] + px[nt * 64 + lane];
            hw[lane] = 0u;
#pragma unroll
            for (int nt = 0; nt < 4; ++nt) { const int e = 16 * nt + r; const float cc1 = c1[e], cc0 = c0[e], rb = rbias[e];
#pragma unroll
                for (int i = 0; i < 4; ++i) { const int rw_ = 4 * kq + i; const float lg = srstd[F.wave * 16 + rw_] * (acc[nt][i] - smean[F.wave * 16 + rw_] * cc1) + cc0;
                    const float s = 1.f / (1.f + expf(-lg)); sc[rw_ * 65 + e] = s; chs[rw_ * 65 + e] = s + rb; } }
            LDS_WAIT(); asm volatile("" ::: "memory");
            if (lane < 16) {
                const LAS float* ch = chs + lane * 65; const LAS float* so = sc + lane * 65;
                float gs[8];
#pragma unroll
                for (int gi = 0; gi < 8; ++gi) { float m1 = -__builtin_inff(), m2 = -__builtin_inff();
#pragma unroll
                    for (int i = 0; i < 8; ++i) { const float v = ch[gi * 8 + i]; if (v > m1) { m2 = m1; m1 = v; } else if (v > m2) m2 = v; }
                    gs[gi] = m1 + m2; }
                unsigned gmask = 0u;
#pragma unroll
                for (int gi = 0; gi < 8; ++gi) { int cnt = 0;
#pragma unroll
                    for (int gj = 0; gj < 8; ++gj) cnt += (gs[gj] > gs[gi] || (gs[gj] == gs[gi] && gj < gi)) ? 1 : 0;
                    if (cnt < 4) gmask |= 1u << gi; }
                unsigned long long chosen = 0ull; int ei[8]; float ew[8]; float wsum = 0.f;
#pragma unroll
                for (int k = 0; k < 8; ++k) { float best = -__builtin_inff(); int bi = 0;
                    for (int e = 0; e < 64; ++e) { const bool ok = ((gmask >> (e >> 3)) & 1u) && !((chosen >> e) & 1ull); const float v = ch[e]; if (ok && v > best) { best = v; bi = e; } }
                    chosen |= 1ull << bi; ei[k] = bi; ew[k] = so[bi]; wsum += ew[k]; }
                const size_t row = (size_t)grp * 16 + lane; const float sc_ = 2.5f / wsum;
#pragma unroll
                for (int k = 0; k < 8; ++k) { eidx[row * 8 + k] = ei[k]; wts[row * 8 + k] = ew[k] * sc_; atomicAdd((unsigned*)&hw[ei[k]], 1u); }
            }
            LDS_WAIT(); asm volatile("" ::: "memory");
            ghist[(size_t)grp * 64 + lane] = hw[lane];
            }
        }
        __syncthreads();
    }
}

__device__ __forceinline__ void dispatch_phase(Frame& F, int l) {
    LAS int* cnt = (LAS int*)(F.lds + RING_OFF); LAS int* rstart = cnt + 64; LAS int* tstart = rstart + 64; LAS int* lntr = tstart + 64;
    LAS int* part_tot = lntr + 64; LAS int* part_bef = part_tot + 512; LAS int* gbase = part_bef + 512; LAS int* lh = gbase + 256;
    const int* eidx = (const int*)(F.ws + WS_EIDX); const float* wts = (const float*)(F.ws + WS_WTS); const unsigned* ghist = (const unsigned*)(F.ws + WS_GHIST);
    int* slot = (int*)(F.ws + WS_SLOT); int* tok = (int*)(F.ws + WS_TOK); float* gate = (float*)(F.ws + WS_GATE); int* tile_e = (int*)(F.ws + WS_TILE);
    const int NG = T / 16;
    for (int chunk = blockIdx.x; chunk < T / 64; chunk += F.G) {
        { const int e = F.tid & 63, part = F.tid >> 6; int tot = 0, bef = 0; const int g0 = part * (NG / 8), gfirst = chunk * 4;
          for (int gq = g0; gq < g0 + NG / 8; ++gq) { const int v = (int)ghist[(size_t)gq * 64 + e]; tot += v; bef += (gq < gfirst) ? v : 0; }
          part_tot[part * 64 + e] = tot; part_bef[part * 64 + e] = bef; }
        if (F.tid < 256) lh[F.tid] = 0;
        __syncthreads();
        if (F.tid < 64) { int tot = 0, bef = 0;
#pragma unroll
            for (int p = 0; p < 8; ++p) { tot += part_tot[p * 64 + F.tid]; bef += part_bef[p * 64 + F.tid]; }
            cnt[F.tid] = tot; int run = bef;
#pragma unroll
            for (int gl = 0; gl < 4; ++gl) { gbase[gl * 64 + F.tid] = run; run += (int)ghist[(size_t)(chunk * 4 + gl) * 64 + F.tid]; } }
        __syncthreads();
        if (F.tid == 0) { int ts = 0; for (int e = 0; e < 64; ++e) { tstart[e] = ts; rstart[e] = ts * 256; ts += (cnt[e] + 255) >> 8; } lntr[0] = ts; }
        __syncthreads();
        const int a = chunk * 512 + F.tid; const int e = eidx[a]; const int gl = F.tid >> 7;
        const int lr = atomicAdd((int*)&lh[gl * 64 + e], 1);
        const int dest = rstart[e] + gbase[gl * 64 + e] + lr;
        tok[dest] = a >> 3; gate[dest] = wts[a]; slot[a] = dest;
        __syncthreads();
    }
    if (blockIdx.x >= T / 64) {
        { const int e = F.tid & 63, part = F.tid >> 6; int tot = 0; const int g0 = part * (NG / 8);
          for (int gq = g0; gq < g0 + NG / 8; ++gq) tot += (int)ghist[(size_t)gq * 64 + e];
          part_tot[part * 64 + e] = tot; }
        __syncthreads();
        if (F.tid < 64) { int tot = 0;
#pragma unroll
            for (int p = 0; p < 8; ++p) tot += part_tot[p * 64 + F.tid];
            cnt[F.tid] = tot; }
        __syncthreads();
        if (F.tid == 0) { int ts = 0; for (int e = 0; e < 64; ++e) { tstart[e] = ts; rstart[e] = ts * 256; ts += (cnt[e] + 255) >> 8; } lntr[0] = ts; }
        __syncthreads();
    }
    const int ntr = lntr[0], rpad = ntr * 256;
    if (blockIdx.x == 0 && F.tid == 0) { __hip_atomic_store(F.ctl + CW_NT + l, (unsigned)(ntr + 64), RLX_AGENT); __hip_atomic_store(F.ctl + CW_NT + 2 + l, (unsigned)rpad, RLX_AGENT); }
    for (int e = blockIdx.x; e < 64; e += F.G) {
        const int nt_e = (cnt[e] + 255) >> 8;
        for (int i = cnt[e] + F.tid; i < nt_e * 256; i += NWAVES * 64) { tok[rstart[e] + i] = 0; gate[rstart[e] + i] = 0.f; }
        for (int i = F.tid; i < nt_e; i += NWAVES * 64) tile_e[tstart[e] + i] = e;
    }
    for (int i = blockIdx.x * (NWAVES * 64) + F.tid; i < T; i += F.G * NWAVES * 64) { tok[rpad + i] = i; gate[rpad + i] = 1.f; }
    if (blockIdx.x == 0 && F.tid < 64) tile_e[ntr + F.tid] = 64;
}

typedef float f32x2_ __attribute__((ext_vector_type(2)));
template <bool Y8, bool OF32, bool OB16>
__device__ __forceinline__ void combine_ln_phase(Frame& F, int l, const bf16* x1b, float* out, bf16* outb) {
    const int gw = F.vcu * NWAVES + F.wave, NGW = F.G * NWAVES, lane = F.lane;
    const int* slot = (const int*)(F.ws + WS_SLOT); const unsigned char* yp = F.ws + WS_YP; const float* wts = (const float*)(F.ws + WS_WTS);
    const int rpad = (int)__hip_atomic_load(F.ctl + CW_NT + 2 + l, RLX_AGENT);
    const float* g = F.in[16] + l * D; const float* bta = F.in[17] + l * D;
    constexpr float YS = Y8 ? (1.f / 16.f) : 1.f; constexpr int YB = Y8 ? 1 : 2;
    for (int row = gw; row < T; row += NGW) {
        float v[4][8];
#pragma unroll
        for (int j = 0; j < 4; ++j) { const v4u w = *((const GAS v4u*)(x1b + (size_t)row * D) + lane + 64 * j);
            v[j][0] = bf_lo(w.x) * ALPHA; v[j][1] = bf_hi(w.x) * ALPHA; v[j][2] = bf_lo(w.y) * ALPHA; v[j][3] = bf_hi(w.y) * ALPHA;
            v[j][4] = bf_lo(w.z) * ALPHA; v[j][5] = bf_hi(w.z) * ALPHA; v[j][6] = bf_lo(w.w) * ALPHA; v[j][7] = bf_hi(w.w) * ALPHA; }
        int src[9]; float gw_[9];
#pragma unroll
        for (int k = 0; k < 8; ++k) { src[k] = __builtin_amdgcn_readfirstlane(slot[(size_t)row * 8 + k]); gw_[k] = YS * __builtin_bit_cast(float, __builtin_amdgcn_readfirstlane(__builtin_bit_cast(int, wts[(size_t)row * 8 + k]))); }
        src[8] = rpad + row; gw_[8] = YS;
#pragma unroll
        for (int k = 0; k < 9; ++k) { if (k % 3 == 0) asm volatile("" ::: "memory"); const unsigned char* yr = yp + (size_t)src[k] * (D * YB); const float gk = gw_[k];
#pragma unroll
            for (int j = 0; j < 4; ++j) {
                if constexpr (Y8) { const v2u w = *((const GAS v2u*)yr + lane + 64 * j);
                    const f32x2_ a = __builtin_amdgcn_cvt_pk_f32_fp8((int)w.x, false), b = __builtin_amdgcn_cvt_pk_f32_fp8((int)w.x, true), c = __builtin_amdgcn_cvt_pk_f32_fp8((int)w.y, false), d = __builtin_amdgcn_cvt_pk_f32_fp8((int)w.y, true);
                    v[j][0] += gk * a.x; v[j][1] += gk * a.y; v[j][2] += gk * b.x; v[j][3] += gk * b.y; v[j][4] += gk * c.x; v[j][5] += gk * c.y; v[j][6] += gk * d.x; v[j][7] += gk * d.y; }
                else { const v4u w = *((const GAS v4u*)yr + lane + 64 * j);
                    v[j][0] += gk * bf_lo(w.x); v[j][1] += gk * bf_hi(w.x); v[j][2] += gk * bf_lo(w.y); v[j][3] += gk * bf_hi(w.y); v[j][4] += gk * bf_lo(w.z); v[j][5] += gk * bf_hi(w.z); v[j][6] += gk * bf_lo(w.w); v[j][7] += gk * bf_hi(w.w); } } }
        float s = 0.f;
#pragma unroll
        for (int j = 0; j < 4; ++j)
#pragma unroll
            for (int i = 0; i < 8; ++i) s += v[j][i];
        const float mean = wave_sum(s) * (1.f / D); float s2 = 0.f;
#pragma unroll
        for (int j = 0; j < 4; ++j)
#pragma unroll
            for (int i = 0; i < 8; ++i) { v[j][i] -= mean; s2 += v[j][i] * v[j][i]; }
        const float rstd = 1.f / sqrtf(wave_sum(s2) * (1.f / D) + LN_EPS);
#pragma unroll
        for (int j = 0; j < 4; ++j) { const int c0 = 8 * lane + 512 * j;
            const f32x4 g0 = *(const GAS f32x4*)(g + c0), g1 = *(const GAS f32x4*)(g + c0 + 4), b0 = *(const GAS f32x4*)(bta + c0), b1 = *(const GAS f32x4*)(bta + c0 + 4);
            const f32x4 o0 = (f32x4){v[j][0], v[j][1], v[j][2], v[j][3]} * rstd * g0 + b0, o1 = (f32x4){v[j][4], v[j][5], v[j][6], v[j][7]} * rstd * g1 + b1;
            if constexpr (OF32) { GAS f32x4* xo = (GAS f32x4*)(out + (size_t)row * D + c0); xo[0] = o0; xo[1] = o1; }
            if constexpr (OB16) { v4u w; w.x = pk2(o0.x, o0.y); w.y = pk2(o0.z, o0.w); w.z = pk2(o1.x, o1.y); w.w = pk2(o1.z, o1.w); *(GAS v4u*)(outb + (size_t)row * D + c0) = w; } }
    }
}
#ifndef P1_CVT_LIMIT
#define P1_CVT_LIMIT 2400
#endif
#ifndef CVT_ATT_GROUPS
#define CVT_ATT_GROUPS 20
#endif
#ifndef DOWN_ALIGN
#define DOWN_ALIGN true
#endif
struct Args { const float* in[18]; float* out; unsigned char* ws; int ph_lo, ph_hi; };
__global__ void __launch_bounds__(NWAVES * 64, 2) yoco_fwd(Args args) {
    extern __shared__ __attribute__((aligned(16))) unsigned char lds[];
    Frame F;
    F.lds = (LAS unsigned char*)lds;
    F.tid = threadIdx.x; F.lane = F.tid & 63; F.wave = __builtin_amdgcn_readfirstlane(F.tid >> 6);
    F.G = gridDim.x; { const int bx = blockIdx.x; F.vcu = (F.G % 8 == 0) ? (bx % 8) * (F.G / 8) + bx / 8 : bx; }
    unsigned char* ws = args.ws; F.ws = ws;
    F.ctl = (gu32*)(ws + WS_CTL);
#pragma unroll
    for (int i = 0; i < 18; ++i) F.in[i] = args.in[i];
    F.out = args.out;
    for (int u = F.tid; u < (LDS_BYTES - LDSCTL_OFF) / 4; u += NWAVES * 64) ((LAS unsigned*)(F.lds + LDSCTL_OFF))[u] = 0u;
    __syncthreads();
    XcdBarrier bar; bar.bar = (unsigned*)(F.ctl + CW_BAR); bar.x = 0; bar.st = nullptr;
    if (!MK_PER_PHASE) bar = xcd_barrier_post((unsigned*)(F.ctl + CW_BAR), (volatile LAS unsigned*)(F.lds + MISC_OFF) + 8);
    const int lo = args.ph_lo, hi = args.ph_hi;
#define IN(k) (lo <= (k) && (k) < hi)
#define SEAM(k) do { if (IN(k) && IN((k) + 1)) xcd_barrier(bar); } while (0)
#ifndef DUP_MASK
#define DUP_MASK 0
#endif
#define DUP(k) ((DUP_MASK >> (k)) & 1)
#define REP(k) _Pragma("unroll") for (int rep_ = 0; rep_ <= DUP(k); ++rep_)
    bf16* XB = (bf16*)(ws + WS_XB); bf16* QB = (bf16*)(ws + WS_QB); bf16* KB = (bf16*)(ws + WS_KB); bf16* VB = (bf16*)(ws + WS_VB); bf16* AO = (bf16*)(ws + WS_AO);
    bf16* HM = (bf16*)(ws + WS_Y1);
    unsigned char* X1Q = ws + WS_X1; bf16* X1B = (bf16*)(ws + WS_X1B); bf16* ACT = (bf16*)(ws + WS_ACT); bf16* YP = (bf16*)(ws + WS_YP); float* X2 = (float*)(ws + WS_X2);
    const int* tokp = (const int*)(ws + WS_TOK); const float* gatep = (const float*)(ws + WS_GATE); const int* tile_e = (const int*)(ws + WS_TILE);

    if (IN(0)) REP(0) { if (rep_) xcd_barrier(bar); asm volatile("" : "+v"(F.tid)); F.lane = F.tid & 63; p0_prologue(F); } SEAM(0);
    if (IN(1)) REP(1) { if (rep_) xcd_barrier(bar); asm volatile("" : "+v"(F.tid)); F.lane = F.tid & 63;
        p1_scan(F);
        if (F.G == 256 && P1_CVT_LIMIT > 0 && (int)(blockIdx.x >> 3) >= 24) { if (rep_ == 0) convert_weights<true>(F, (LAS float*)(F.lds + RING_OFF + F.wave * 16384), P1_CVT_LIMIT); }
        else {
        pg8::Gemm g{XB, (const bf16*)(ws + WS_WQKV_A), D, nullptr}; pg8::StaticOrder S; S.init(T, NQKV_A, (F.G == 256 && P1_CVT_LIMIT > 0) ? 192 : F.G, (int)blockIdx.x);
        pg8::EpiQKVn E{QB, (size_t)(WS_KB - WS_QB) / 2, QSCALE_A, (float*)(ws + WS_NRM), (float*)(ws + WS_NRM) + 64 * SEQ};
        pg8::gemm_phase<pg8::EpiQKVn, pg8::StaticOrder, true, false>(F.lds + RING_OFF, g, S, E);
        }
    } SEAM(1);
    if (IN(2)) REP(2) { if (rep_) xcd_barrier(bar); asm volatile("" : "+v"(F.tid)); F.lane = F.tid & 63;
        for (int L = blockIdx.x; L < 1024; L += F.G) fox::fox_jlo_item((char*)lds + RING_OFF, L, (const float*)(ws + WS_CB), (const float*)(ws + WS_NRM), (const float*)(ws + WS_NRM) + 64 * SEQ, (int*)(ws + WS_NRM + 2 * 64 * SEQ * 4)); } SEAM(2);
    if (IN(3)) for (int rep_ = 0, nrep_ = (DUP(3) && hi >= N_PHASES) ? 2 : 1; rep_ < nrep_; ++rep_) { if (rep_) xcd_barrier(bar); asm volatile("" : "+v"(F.tid)); F.lane = F.tid & 63;
        const bool att_first = (int)(blockIdx.x >> 3) < CVT_ATT_GROUPS;
        if (!att_first && rep_ == 0) convert_weights<true>(F, (LAS float*)(F.lds + RING_OFF + F.wave * 16384));
        fox::fox_phase((char*)lds + RING_OFF, (const fox::bf16*)QB, (const fox::bf16*)KB, (const fox::bf16*)VB, (fox::bf16*)AO, (const float*)(ws + WS_CB), (unsigned*)(F.ctl + CW_FOXQ), (const int*)(ws + WS_NRM + 2 * 64 * SEQ * 4));
        __syncthreads();
        if (att_first && rep_ == 0) convert_weights<true>(F, (LAS float*)(F.lds + RING_OFF + F.wave * 16384)); } SEAM(3);
    if (IN(4)) REP(4) { if (rep_) xcd_barrier(bar); asm volatile("" : "+v"(F.tid)); F.lane = F.tid & 63;
        pg8::Gemm g{AO, (const bf16*)(ws + WS_WO_A), D, nullptr}; pg8::StaticOrder S; S.init(T, D, F.G, (int)blockIdx.x);
        pg8::EpiBf16 E{HM, D, 0, 0, 1.f};
        pg8::gemm_phase<pg8::EpiBf16, pg8::StaticOrder, true, false>(F.lds + RING_OFF, g, S, E);
    } SEAM(4);
    if (IN(5)) REP(5) { if (rep_) xcd_barrier(bar); asm volatile("" : "+v"(F.tid)); F.lane = F.tid & 63; ln_router_phase<true>(F, 0, F.in[0], HM, X1B, (FP8_MASK & 1) ? X1Q : nullptr); } SEAM(5);
    if (IN(6)) REP(6) { if (rep_) xcd_barrier(bar); asm volatile("" : "+v"(F.tid)); F.lane = F.tid & 63; dispatch_phase(F, 0); } SEAM(6);
    if (IN(7)) REP(7) { if (rep_) xcd_barrier(bar); asm volatile("" : "+v"(F.tid)); F.lane = F.tid & 63;
        const int ntl = (int)__hip_atomic_load(F.ctl + CW_NT + 0, RLX_AGENT);
        pg8::GroupedOrder S; S.init(ntl, 4, F.G, (int)blockIdx.x, tile_e);
        if constexpr ((FP8_MASK >> 0) & 1) { pg8::Gemm g{(const bf16*)X1Q, (const bf16*)(ws + WS_WGU), D / 2, tokp}; pg8::EpiSwiglu8 E{(unsigned char*)ACT, EH, 1.f};
            pg8::gemm_phase<pg8::EpiSwiglu8, pg8::GroupedOrder, true, true, true>(F.lds + RING_OFF, g, S, E); }
        else { pg8::Gemm g{X1B, (const bf16*)(ws + WS_WGU), D, tokp}; pg8::EpiSwiglu E{ACT, EH};
            pg8::gemm_phase<pg8::EpiSwiglu, pg8::GroupedOrder, true, true>(F.lds + RING_OFF, g, S, E); }
    } SEAM(7);
    if (IN(8)) REP(8) { if (rep_) xcd_barrier(bar); asm volatile("" : "+v"(F.tid)); F.lane = F.tid & 63;
        const int ntl = (int)__hip_atomic_load(F.ctl + CW_NT + 0, RLX_AGENT);
        pg8::GroupedOrder S; S.init(ntl, 8, F.G, (int)blockIdx.x, tile_e);
        if constexpr ((FP8_MASK >> 0) & 1) { pg8::Gemm g{ACT, (const bf16*)(ws + WS_WD), EH / 2, nullptr}; pg8::EpiFp8Y E{(unsigned char*)YP, D};
            pg8::gemm_phase<pg8::EpiFp8Y, pg8::GroupedOrder, DOWN_ALIGN, false, true>(F.lds + RING_OFF, g, S, E); }
        else { pg8::Gemm g{ACT, (const bf16*)(ws + WS_WD), EH, nullptr}; pg8::EpiBf16NT E{YP, D, 0, 0, 1.f};
            pg8::gemm_phase<pg8::EpiBf16NT, pg8::GroupedOrder, DOWN_ALIGN, false>(F.lds + RING_OFF, g, S, E); }
    } SEAM(8);
    if (IN(9)) REP(9) { if (rep_) xcd_barrier(bar); asm volatile("" : "+v"(F.tid)); F.lane = F.tid & 63; combine_ln_phase<(FP8_MASK & 1) != 0, false, true>(F, 0, X1B, nullptr, XB); } SEAM(9);
    if (IN(10)) REP(10) { if (rep_) xcd_barrier(bar); asm volatile("" : "+v"(F.tid)); F.lane = F.tid & 63;
        pg8::Gemm g{XB, (const bf16*)(ws + WS_WQKV_B), D, nullptr}; pg8::StaticOrder S; S.init(T, NQKV_B, F.G, (int)blockIdx.x);
        pg8::EpiRope E{QB, KB, KB + (size_t)T * 256, (const float*)(ws + WS_ROPE), (const float*)(ws + WS_ROPE) + SEQ * 32, QSCALE_B};
        pg8::gemm_phase<pg8::EpiRope, pg8::StaticOrder, true, false>(F.lds + RING_OFF, g, S, E);
    } SEAM(10);
    if (IN(11)) REP(11) { if (rep_) xcd_barrier(bar); asm volatile("" : "+v"(F.tid)); F.lane = F.tid & 63; swa::swa_phase((char*)lds + RING_OFF, (const swa::bf16*)QB, (const swa::bf16*)KB, (const swa::bf16*)(KB + (size_t)T * 256), (swa::bf16*)AO, F.in[6], (int)blockIdx.x, F.G); } SEAM(11);
    if (IN(12)) REP(12) { if (rep_) xcd_barrier(bar); asm volatile("" : "+v"(F.tid)); F.lane = F.tid & 63;
        pg8::Gemm g{AO, (const bf16*)(ws + WS_WO_B), D, nullptr}; pg8::StaticOrder S; S.init(T, D, F.G, (int)blockIdx.x);
        pg8::EpiBf16 E{HM, D, 0, 0, 1.f};
        pg8::gemm_phase<pg8::EpiBf16, pg8::StaticOrder, true, false>(F.lds + RING_OFF, g, S, E);
    } SEAM(12);
    if (IN(13)) REP(13) { if (rep_) xcd_barrier(bar); asm volatile("" : "+v"(F.tid)); F.lane = F.tid & 63; ln_router_phase<false>(F, 1, XB, HM, X1B, (FP8_MASK & 2) ? X1Q : nullptr); } SEAM(13);
    if (IN(14)) REP(14) { if (rep_) xcd_barrier(bar); asm volatile("" : "+v"(F.tid)); F.lane = F.tid & 63; dispatch_phase(F, 1); } SEAM(14);
    if (IN(15)) REP(15) { if (rep_) xcd_barrier(bar); asm volatile("" : "+v"(F.tid)); F.lane = F.tid & 63;
        const int ntl = (int)__hip_atomic_load(F.ctl + CW_NT + 1, RLX_AGENT);
        pg8::GroupedOrder S; S.init(ntl, 4, F.G, (int)blockIdx.x, tile_e);
        if constexpr ((FP8_MASK >> 1) & 1) { pg8::Gemm g{(const bf16*)X1Q, (const bf16*)(ws + WS_WGU + WGU_L), D / 2, tokp}; pg8::EpiSwiglu8 E{(unsigned char*)ACT, EH, 1.f};
            pg8::gemm_phase<pg8::EpiSwiglu8, pg8::GroupedOrder, true, true, true>(F.lds + RING_OFF, g, S, E); }
        else { pg8::Gemm g{X1B, (const bf16*)(ws + WS_WGU + WGU_L), D, tokp}; pg8::EpiSwiglu E{ACT, EH};
            pg8::gemm_phase<pg8::EpiSwiglu, pg8::GroupedOrder, true, true>(F.lds + RING_OFF, g, S, E); }
    } SEAM(15);
    if (IN(16)) REP(16) { if (rep_) xcd_barrier(bar); asm volatile("" : "+v"(F.tid)); F.lane = F.tid & 63;
        const int ntl = (int)__hip_atomic_load(F.ctl + CW_NT + 1, RLX_AGENT);
        pg8::GroupedOrder S; S.init(ntl, 8, F.G, (int)blockIdx.x, tile_e);
        if constexpr ((FP8_MASK >> 1) & 1) { pg8::Gemm g{ACT, (const bf16*)(ws + WS_WD + WD_L), EH / 2, nullptr}; pg8::EpiFp8Y E{(unsigned char*)YP, D};
            pg8::gemm_phase<pg8::EpiFp8Y, pg8::GroupedOrder, DOWN_ALIGN, false, true>(F.lds + RING_OFF, g, S, E); }
        else { pg8::Gemm g{ACT, (const bf16*)(ws + WS_WD + WD_L), EH, nullptr}; pg8::EpiBf16NT E{YP, D, 0, 0, 1.f};
            pg8::gemm_phase<pg8::EpiBf16NT, pg8::GroupedOrder, DOWN_ALIGN, false>(F.lds + RING_OFF, g, S, E); }
    } SEAM(16);
    if (IN(17)) REP(17) { if (rep_) xcd_barrier(bar); asm volatile("" : "+v"(F.tid)); F.lane = F.tid & 63; combine_ln_phase<(FP8_MASK & 2) != 0, true, false>(F, 1, X1B, F.out, nullptr); }
#undef IN
#undef SEAM
}

#ifndef HOST_DUP_MASK
#define HOST_DUP_MASK 0
#endif
extern "C" void kernel_launch(void* const* d_in, const int* in_sizes, int n_in, void* d_out, int out_size, void* d_ws, size_t ws_size, hipStream_t stream) {
    static int grid = 0;
    if (grid == 0) {
        if (n_in != 18 || in_sizes[0] != T * D || out_size != T * D || ws_size < WS_END) { fprintf(stderr, "kernel_launch: unexpected shapes (n_in %d, in0 %d, out %d, ws %zu); nothing launched\n", n_in, n_in > 0 ? in_sizes[0] : -1, out_size, ws_size); grid = -1; return; }
        int dev = 0, cus = 0, per_cu = 0;
        if (hipGetDevice(&dev) != hipSuccess || hipDeviceGetAttribute(&cus, hipDeviceAttributeMultiprocessorCount, dev) != hipSuccess) { grid = -1; return; }
        if (hipFuncSetAttribute((const void*)yoco_fwd, hipFuncAttributeMaxDynamicSharedMemorySize, LDS_BYTES) != hipSuccess) { fprintf(stderr, "kernel_launch: hipFuncSetAttribute failed\n"); grid = -1; return; }
        if (hipOccupancyMaxActiveBlocksPerMultiprocessor(&per_cu, (const void*)yoco_fwd, NWAVES * 64, LDS_BYTES) != hipSuccess || per_cu < 1)
            fprintf(stderr, "kernel_launch: note: occupancy query reports %d workgroups per CU\n", per_cu);
        (void)hipGetLastError();
        grid = cus;
    }
    if (grid < 0) return;
    if (hipMemsetAsync((char*)d_ws + WS_CTL, 0, CTL_ZERO_BYTES, stream) != hipSuccess) return;
    Args a{};
    for (int i = 0; i < 18; ++i) a.in[i] = (const float*)d_in[i];
    a.out = (float*)d_out; a.ws = (unsigned char*)d_ws;
#if MK_PER_PHASE
    for (int p = 0; p < N_PHASES; ++p) for (int r = 0; r <= ((HOST_DUP_MASK >> p) & 1); ++r) { a.ph_lo = p; a.ph_hi = p + 1; hipLaunchKernelGGL(yoco_fwd, dim3(grid), dim3(NWAVES * 64), LDS_BYTES, stream, a); }
#else
    a.ph_lo = 0; a.ph_hi = N_PHASES;
    hipLaunchKernelGGL(yoco_fwd, dim3(grid), dim3(NWAVES * 64), LDS_BYTES, stream, a);
#endif
    const hipError_t le = hipPeekAtLastError();
    if (le != hipSuccess) fprintf(stderr, "kernel_launch: launch failed: %s\n", hipGetErrorName(le));
}
```

```cpp
#include <hip/hip_runtime.h>
#include <hip/hip_bf16.h>
#include <cstdio>
#include <cstdint>
#include <cmath>
#define MK_PER_PHASE 0
namespace pg8 {
#define PG8_LAS __attribute__((address_space(3)))
typedef unsigned short bf16_t;
typedef short bf16x8 __attribute__((ext_vector_type(8)));
typedef float f32x4 __attribute__((ext_vector_type(4)));
typedef unsigned u32x4 __attribute__((ext_vector_type(4)));
typedef int v8i __attribute__((ext_vector_type(8)));
typedef unsigned u32x2 __attribute__((ext_vector_type(2)));
constexpr int BM = 256, BK = 64, HALF = 128, HTB = HALF * BK * 2  , STAGE_BYTES = 8 * HTB, NXCD = 8, WGM = 8;

__host__ __device__ __forceinline__ int lds_byte(int r, int c) { const int st = (r >> 4) * 2 + (c >> 5), rr = r & 15, cc = c & 31, ob = rr * 64 + cc * 2; return st * 1024 + (ob ^ (((ob >> 9) & 1) << 5)); }
__host__ __device__ __forceinline__ void stage_rc(int b, int& R, int& C) { const int st = b / 1024, sb = b % 1024, swz = sb ^ (((sb >> 9) & 1) << 5); R = (st >> 1) * 16 + swz / 64; C = (st & 1) * 32 + (swz % 64) / 2; }
__host__ __device__ __forceinline__ int perm32(int rho) { const int n = rho >> 4, i = rho & 15; return 8 * (i >> 2) + 4 * n + (i & 3); }

struct Unit { int pm, pn, pb; };
struct Gemm { const bf16_t* A; const bf16_t* Bt; int K; const int* rowtab; };

struct StaticOrder {
    int nM, nN, nwg, G, c;
    __host__ __device__ void init(int M, int N, int G_, int c_) { nM = M / BM; nN = N / BM; nwg = nM * nN; G = G_; c = c_; }
    __host__ __device__ bool next(int i, Unit& u) const {
        const long L = (long)i * G + c; if (L >= nwg) return false;
        int wgid = (int)L; { const int q = nwg / NXCD, r = nwg % NXCD, xcd = wgid % NXCD, off = wgid / NXCD; wgid = (xcd < r ? xcd * (q + 1) : r * (q + 1) + (xcd - r) * q) + off; }
        const int nig = WGM * nN, gid = wgid / nig, fm = gid * WGM, gsz = (nM - fm) < WGM ? (nM - fm) : WGM;
        u.pm = fm + ((wgid % nig) % gsz); u.pn = (wgid % nig) / gsz; u.pb = u.pn; return true;
    }
};
struct GroupedOrder {
    int nN, nwg, G, c; const int* tile_e;
    __device__ void init(int ntiles, int nN_, int G_, int c_, const int* te) { nN = nN_; nwg = ntiles * nN_; G = G_; c = c_; tile_e = te; }
    __device__ bool next(int i, Unit& u) const {
        const long L = (long)i * G + c; if (L >= nwg) return false;
        int wgid = (int)L; { const int q = nwg / NXCD, r = nwg % NXCD, xcd = wgid % NXCD, off = wgid / NXCD; wgid = (xcd < r ? xcd * (q + 1) : r * (q + 1) + (xcd - r) * q) + off; }
        const int t = wgid / nN; u.pm = t; u.pn = wgid - t * nN; u.pb = __builtin_amdgcn_readfirstlane(tile_e[t]) * nN + u.pn; return true;
    }
};

__device__ __forceinline__ unsigned cvt_pk_bf16(float lo, float hi) { unsigned r; asm volatile("v_cvt_pk_bf16_f32 %0, %1, %2" : "=v"(r) : "v"(lo), "v"(hi)); return r; }

template <bool NT> struct EpiBf16T {
    static constexpr int PERM = 1; static constexpr int NST = 16; static constexpr int WSCALE8 = 0x7F7F7F7F;
    bf16_t* O; int ldc; int split_cols; size_t split_stride; float scale0;
    __device__ __forceinline__ void operator()(const f32x4 (&acc)[2][2][4][2], const Unit& u, int wr, int wc, int fr, int fq) const {
        const int row0 = u.pm * BM + wr * 64 + fr; int colt = u.pn * BM; bf16_t* base = O;
        float sc = 1.f; if (split_cols) { const int t = colt / split_cols; base += (size_t)t * split_stride; colt -= t * split_cols; if (t == 0) sc = scale0; }
        const int col0 = colt + wc * 32 + 8 * fq;
#pragma unroll
        for (int ai = 0; ai < 2; ++ai)
#pragma unroll
            for (int m = 0; m < 4; ++m) { bf16_t* rowp = base + (size_t)(row0 + ai * HALF + m * 16) * ldc + col0;
#pragma unroll
                for (int bj = 0; bj < 2; ++bj) { f32x4 v0 = acc[ai][bj][m][0] * sc, v1 = acc[ai][bj][m][1] * sc;
                    u32x4 w; w.x = cvt_pk_bf16(v0[0], v0[1]); w.y = cvt_pk_bf16(v0[2], v0[3]); w.z = cvt_pk_bf16(v1[0], v1[1]); w.w = cvt_pk_bf16(v1[2], v1[3]);
                    if constexpr (NT) __builtin_nontemporal_store(w, (u32x4*)(rowp + bj * HALF)); else *(u32x4*)(rowp + bj * HALF) = w; } }
    }
};
typedef EpiBf16T<false> EpiBf16; typedef EpiBf16T<true> EpiBf16NT;
struct EpiQKVn {
    static constexpr int PERM = 1; static constexpr int NST = 16; static constexpr int WSCALE8 = 0x7F7F7F7F;
    bf16_t* O; size_t split_stride; float scale0; float* nq; float* nk;
    __device__ __forceinline__ void operator()(const f32x4 (&acc)[2][2][4][2], const Unit& u, int wr, int wc, int fr, int fq) const {
        const int row0 = u.pm * BM + wr * 64 + fr; int colt = u.pn * BM; const int t = colt / 2048; bf16_t* base = O + (size_t)t * split_stride; colt -= t * 2048;
        const float sc = t == 0 ? scale0 : 1.f; float* nrm = t == 0 ? nq : nk;
        const int col0 = colt + wc * 32 + 8 * fq;
#pragma unroll
        for (int ai = 0; ai < 2; ++ai)
#pragma unroll
            for (int m = 0; m < 4; ++m) { const int row = row0 + ai * HALF + m * 16; bf16_t* rowp = base + (size_t)row * 2048 + col0;
#pragma unroll
                for (int bj = 0; bj < 2; ++bj) { f32x4 v0 = acc[ai][bj][m][0] * sc, v1 = acc[ai][bj][m][1] * sc;
                    u32x4 w; w.x = cvt_pk_bf16(v0[0], v0[1]); w.y = cvt_pk_bf16(v0[2], v0[3]); w.z = cvt_pk_bf16(v1[0], v1[1]); w.w = cvt_pk_bf16(v1[2], v1[3]);
                    *(u32x4*)(rowp + bj * HALF) = w;
                    if (t < 2) { float ss = (v0[0] * v0[0] + v0[1] * v0[1]) + (v0[2] * v0[2] + v0[3] * v0[3]) + (v1[0] * v1[0] + v1[1] * v1[1]) + (v1[2] * v1[2] + v1[3] * v1[3]);
                        ss += __shfl_xor(ss, 16); ss += __shfl_xor(ss, 32);
                        if (fq == 0) { const int head = (colt >> 7) + bj; atomicAdd(nrm + ((size_t)((row >> 12) * 16 + head) << 12) + (row & 4095), ss); } } } }
    }
};
struct EpiSwiglu {
    static constexpr int PERM = 1; static constexpr int NST = 8; static constexpr int WSCALE8 = 0x7F7F7F7F;
    bf16_t* O; int ldc;
    __device__ __forceinline__ void operator()(const f32x4 (&acc)[2][2][4][2], const Unit& u, int wr, int wc, int fr, int fq) const {
        const int col0 = u.pn * HALF + wc * 32 + 8 * fq;
#pragma unroll
        for (int ai = 0; ai < 2; ++ai)
#pragma unroll
            for (int m = 0; m < 4; ++m) { bf16_t* rowp = O + (size_t)(u.pm * BM + ai * HALF + wr * 64 + m * 16 + fr) * ldc + col0;
                float a[8];
#pragma unroll
                for (int n = 0; n < 2; ++n)
#pragma unroll
                    for (int j = 0; j < 4; ++j) { const float g = acc[ai][0][m][n][j], up = acc[ai][1][m][n][j];
                        a[n * 4 + j] = g * __builtin_amdgcn_rcpf(1.f + __builtin_amdgcn_exp2f(-1.4426950408889634f * g)) * up; }
                u32x4 w; w.x = cvt_pk_bf16(a[0], a[1]); w.y = cvt_pk_bf16(a[2], a[3]); w.z = cvt_pk_bf16(a[4], a[5]); w.w = cvt_pk_bf16(a[6], a[7]);
                *(u32x4*)rowp = w; }
    }
};
__device__ __forceinline__ unsigned pk4_fp8(float a, float b, float c, float d) { int w = 0; w = __builtin_amdgcn_cvt_pk_fp8_f32(a, b, w, false); w = __builtin_amdgcn_cvt_pk_fp8_f32(c, d, w, true); return (unsigned)w; }
struct EpiFp8Y {
    static constexpr int PERM = 2; static constexpr int NST = 8; static constexpr int WSCALE8 = 0x7D7D7D7D;
    unsigned char* O; int ldc;
    __device__ __forceinline__ void operator()(const f32x4 (&acc)[2][2][4][2], const Unit& u, int wr, int wc, int fr, int fq) const {
        const int col0 = u.pn * BM + wc * 64 + 16 * fq;
#pragma unroll
        for (int ai = 0; ai < 2; ++ai)
#pragma unroll
            for (int m = 0; m < 4; ++m) { unsigned char* rowp = O + (size_t)(u.pm * BM + ai * HALF + wr * 64 + m * 16 + fr) * ldc + col0;
                const f32x4 a = acc[ai][0][m][0], b = acc[ai][0][m][1], c = acc[ai][1][m][0], d = acc[ai][1][m][1];
                u32x4 w; w.x = pk4_fp8(a[0], a[1], a[2], a[3]); w.y = pk4_fp8(b[0], b[1], b[2], b[3]); w.z = pk4_fp8(c[0], c[1], c[2], c[3]); w.w = pk4_fp8(d[0], d[1], d[2], d[3]);
                *(u32x4*)rowp = w; }
    }
};
struct EpiSwiglu8 {
    static constexpr int PERM = 1; static constexpr int NST = 8; static constexpr int WSCALE8 = 0x79797979;
    unsigned char* O; int ldc; float iscale;
    __device__ __forceinline__ void operator()(const f32x4 (&acc)[2][2][4][2], const Unit& u, int wr, int wc, int fr, int fq) const {
        const int col0 = u.pn * HALF + wc * 32 + 8 * fq;
#pragma unroll
        for (int ai = 0; ai < 2; ++ai)
#pragma unroll
            for (int m = 0; m < 4; ++m) { unsigned char* rowp = O + (size_t)(u.pm * BM + ai * HALF + wr * 64 + m * 16 + fr) * ldc + col0;
                float a[8];
#pragma unroll
                for (int n = 0; n < 2; ++n)
#pragma unroll
                    for (int j = 0; j < 4; ++j) { const float g = acc[ai][0][m][n][j] * iscale, up = acc[ai][1][m][n][j] * iscale;
                        a[n * 4 + j] = g * __builtin_amdgcn_rcpf(1.f + __builtin_amdgcn_exp2f(-1.4426950408889634f * g)) * up; }
                u32x2 w; w.x = pk4_fp8(a[0], a[1], a[2], a[3]); w.y = pk4_fp8(a[4], a[5], a[6], a[7]);
                *(u32x2*)rowp = w; }
    }
};
struct EpiRope {
    static constexpr int PERM = 1; static constexpr int NST = 16; static constexpr int WSCALE8 = 0x7F7F7F7F;
    bf16_t* Q; bf16_t* Kc; bf16_t* Vc; const float* cs; const float* sn; float qscale;
    __device__ __forceinline__ void operator()(const f32x4 (&acc)[2][2][4][2], const Unit& u, int wr, int wc, int fr, int fq) const {
        if (u.pn == 9) {
#pragma unroll
            for (int ai = 0; ai < 2; ++ai)
#pragma unroll
                for (int m = 0; m < 4; ++m) { bf16_t* rowp = Vc + (size_t)(u.pm * BM + ai * HALF + wr * 64 + m * 16 + fr) * 256 + wc * 32 + 8 * fq;
#pragma unroll
                    for (int bj = 0; bj < 2; ++bj) { const f32x4 v0 = acc[ai][bj][m][0], v1 = acc[ai][bj][m][1];
                        u32x4 w; w.x = cvt_pk_bf16(v0[0], v0[1]); w.y = cvt_pk_bf16(v0[2], v0[3]); w.z = cvt_pk_bf16(v1[0], v1[1]); w.w = cvt_pk_bf16(v1[2], v1[3]);
                        *(u32x4*)(rowp + bj * HALF) = w; } }
            return;
        }
        const bool isq = u.pn < 8; const float sc = isq ? qscale : 1.f;
        bf16_t* base = isq ? Q + u.pn * 256 : Kc; const int ldo = isq ? 2048 : 256;
#pragma unroll
        for (int ai = 0; ai < 2; ++ai)
#pragma unroll
            for (int m = 0; m < 4; ++m) { int fq_ = fq; asm volatile("" : "+v"(fq_)); const int row = u.pm * BM + ai * HALF + wr * 64 + m * 16 + fr; const int pos = row & 4095;
                const unsigned to_ = (unsigned)(pos * 32 + 8 * fq_) * 4u;
                const f32x4 c0 = *(const f32x4*)((const char*)cs + to_), c1 = *(const f32x4*)((const char*)cs + to_ + 16);
                const f32x4 s0 = *(const f32x4*)((const char*)sn + to_), s1 = *(const f32x4*)((const char*)sn + to_ + 16);
                const f32x4 a0 = acc[ai][0][m][0], a1 = acc[ai][0][m][1], b0 = acc[ai][1][m][0], b1 = acc[ai][1][m][1];
                const f32x4 x0 = (a0 * c0 - b0 * s0) * sc, x1 = (a1 * c1 - b1 * s1) * sc, y0 = (b0 * c0 + a0 * s0) * sc, y1 = (b1 * c1 + a1 * s1) * sc;
                bf16_t* rowp = base + (size_t)row * ldo + wc * 64 + 8 * fq_;
                u32x4 w; w.x = cvt_pk_bf16(x0[0], x0[1]); w.y = cvt_pk_bf16(x0[2], x0[3]); w.z = cvt_pk_bf16(x1[0], x1[1]); w.w = cvt_pk_bf16(x1[2], x1[3]);
                *(u32x4*)rowp = w;
                w.x = cvt_pk_bf16(y0[0], y0[1]); w.y = cvt_pk_bf16(y0[2], y0[3]); w.z = cvt_pk_bf16(y1[0], y1[1]); w.w = cvt_pk_bf16(y1[2], y1[3]);
                *(u32x4*)(rowp + 32) = w;
                if (m & 1) asm volatile("" ::: "memory"); }
    }
};

__device__ __forceinline__ void glds16s(const void* sbase, unsigned voff, unsigned lds_dst) { unsigned keep;
    asm volatile("s_mov_b32 %0, m0\n\ts_mov_b32 m0, %3\n\ts_nop 0\n\tglobal_load_lds_dwordx4 %1, %2\n\ts_mov_b32 m0, %0" : "=&s"(keep) : "v"(voff), "s"(sbase), "s"(lds_dst) : "memory"); }
template <class Epi, class Sched, bool ALIGN_EPI, bool GATHER, bool FP8 = false>
__device__ __forceinline__ void gemm_phase(PG8_LAS unsigned char* lds, const Gemm g, const Sched& S, const Epi& E) {
    const int tid = threadIdx.x, wid = __builtin_amdgcn_readfirstlane(tid >> 6), lane = tid & 63, wr = wid >> 2, wc = wid & 3, fr = lane & 15, fq = lane >> 4;
    int K = g.K; if constexpr (FP8) asm volatile("" : "+s"(K)); const int nt = K / BK;
    unsigned voffB[2][2], vcur[2][2], vnxt[2][2];
    constexpr int PM = (int)Epi::PERM;
#pragma unroll
    for (int i = 0; i < 2; ++i) { int R, C; stage_rc(tid * 16 + i * 8192, R, C);
        if constexpr (PM == 2) { const int w_ = R >> 5, n_ = (R >> 4) & 1, q_ = (R >> 2) & 3, r_ = R & 3;
#pragma unroll
            for (int h = 0; h < 2; ++h) voffB[h][i] = (unsigned)((64 * w_ + 16 * q_ + 8 * h + 4 * n_ + r_) * K + C) * 2u; }
        else { const int Rb = PM ? ((R & ~31) + perm32(R & 31)) : R; voffB[0][i] = (unsigned)(Rb * K + C) * 2u; voffB[1][i] = voffB[0][i] + (unsigned)(HALF * K * 2); } }
    const size_t kstep = (size_t)(BK * 2);
    const size_t hstep = (size_t)HALF * K * 2;
    const size_t tstep = 2 * hstep;
    const unsigned ldsw = (unsigned)wid * 1024u; const unsigned ldsa = (unsigned)__builtin_amdgcn_readfirstlane((int)((unsigned)(uintptr_t)lds + (unsigned)wid * 1024u));
    const int aoff = lds_byte(wr * 64 + fr, fq * 8), boff = lds_byte(wc * 32 + fr, fq * 8);
#define PG8_SA(b, h) (((b) * 2 + (h)) * HTB)
#define PG8_SB(b, h) ((4 + (b) * 2 + (h)) * HTB)
#define PG8_STAGE(bufoff, gbase, voff) do { _Pragma("unroll") for (int _i = 0; _i < 2; ++_i) { \
        glds16s((const void*)(gbase), (voff)[_i], ldsa + (unsigned)((bufoff) + _i * 8192)); } } while (0)
#define PG8_STAGE_A1(bufoff, gbase, voff2) do { if constexpr (GATHER) PG8_STAGE(bufoff, gbase, (voff2)[1]); else PG8_STAGE(bufoff, (gbase) + hstep, (voff2)[0]); } while (0)
#define PG8_STAGE_B1(bufoff, gbase) do { if constexpr (PM == 2) PG8_STAGE(bufoff, gbase, voffB[1]); else PG8_STAGE(bufoff, (gbase) + hstep, voffB[0]); } while (0)
#define PG8_LDA(dst, b, h) do { _Pragma("unroll") for (int m = 0; m < 4; ++m) _Pragma("unroll") for (int k = 0; k < 2; ++k) dst[m][k] = *(const PG8_LAS bf16x8*)(lds + PG8_SA(b, h) + aoff + m * 2048 + k * 1024); } while (0)
#define PG8_LDB(dst, b, h) do { _Pragma("unroll") for (int n = 0; n < 2; ++n) _Pragma("unroll") for (int k = 0; k < 2; ++k) dst[n][k] = *(const PG8_LAS bf16x8*)(lds + PG8_SB(b, h) + boff + n * 2048 + k * 1024); } while (0)
#define PG8_CAT8(x) __builtin_bit_cast(v8i, __builtin_shufflevector((x)[0], (x)[1], 0, 1, 2, 3, 4, 5, 6, 7, 8, 9, 10, 11, 12, 13, 14, 15))
#define PG8_MMA(ZC, ai, bj, At, Bt) do { __builtin_amdgcn_s_setprio(1); _Pragma("unroll") for (int m = 0; m < 4; ++m) _Pragma("unroll") for (int n = 0; n < 2; ++n) { \
        if constexpr (FP8) { if constexpr (ZC) asm volatile("v_mfma_scale_f32_16x16x128_f8f6f4 %0, %1, %2, 0, %3, %4 op_sel_hi:[0,0,0]" : "=&v"(acc[ai][bj][m][n]) : "v"(PG8_CAT8(Bt[n])), "v"(PG8_CAT8(At[m])), "v"(sc8w), "v"(sc8)); \
            else asm volatile("v_mfma_scale_f32_16x16x128_f8f6f4 %0, %1, %2, %0, %3, %4 op_sel_hi:[0,0,0]" : "+v"(acc[ai][bj][m][n]) : "v"(PG8_CAT8(Bt[n])), "v"(PG8_CAT8(At[m])), "v"(sc8w), "v"(sc8)); } \
        else { acc[ai][bj][m][n] = __builtin_amdgcn_mfma_f32_16x16x32_bf16(Bt[n][0], At[m][0], (ZC) ? (f32x4){0.f, 0.f, 0.f, 0.f} : acc[ai][bj][m][n], 0, 0, 0); \
               acc[ai][bj][m][n] = __builtin_amdgcn_mfma_f32_16x16x32_bf16(Bt[n][1], At[m][1], acc[ai][bj][m][n], 0, 0, 0); } } __builtin_amdgcn_s_setprio(0); } while (0)
#define PG8_WAIT_V(n) asm volatile("s_waitcnt vmcnt(" #n ")" ::: "memory")
#define PG8_WAIT_VN(n) asm volatile("s_waitcnt vmcnt(%0)" :: "i"(n) : "memory")
#define PG8_WAIT_L(n) asm volatile("s_waitcnt lgkmcnt(" #n ")" ::: "memory")
#define PG8_BAR __builtin_amdgcn_s_barrier()
#define PG8_SCHED __builtin_amdgcn_sched_barrier(0)
#define PG8_AOFFS(dst, u_) do { _Pragma("unroll") for (int _h = 0; _h < 2; ++_h) _Pragma("unroll") for (int _i = 0; _i < 2; ++_i) { int R_, C_; stage_rc(tid * 16 + _i * 8192, R_, C_); \
        if constexpr (GATHER) dst[_h][_i] = (unsigned)g.rowtab[(u_).pm * BM + _h * HALF + R_] * (unsigned)(K * 2) + (unsigned)C_ * 2u; \
        else dst[_h][_i] = (unsigned)(R_ * K) * 2u + (unsigned)C_ * 2u + (unsigned)(_h * hstep); } } while (0)
    Unit cur, nxt; int ui = 0;
    if (!S.next(0, cur)) return;
    f32x4 acc[2][2][4][2];
#pragma unroll
    for (int a = 0; a < 2; ++a)
#pragma unroll
        for (int b = 0; b < 2; ++b)
#pragma unroll
            for (int m = 0; m < 4; ++m)
#pragma unroll
                for (int n = 0; n < 2; ++n) acc[a][b][m][n] = (f32x4){0.f, 0.f, 0.f, 0.f};
    bf16x8 At[4][2], B0[2][2], B1[2][2]; const int sc8 = 0x7F7F7F7F; int sc8w = 0x7F7F7F7F; if constexpr (FP8) sc8w = Epi::WSCALE8;
    PG8_AOFFS(vcur, cur);
    const char* cA = GATHER ? (const char*)g.A : (const char*)g.A + (size_t)cur.pm * tstep; const char* cB = (const char*)g.Bt + (size_t)cur.pb * tstep;
    PG8_STAGE(PG8_SB(0, 0), cB, voffB[0]); PG8_STAGE_B1(PG8_SB(0, 1), cB); PG8_STAGE(PG8_SA(0, 0), cA, vcur[0]); PG8_STAGE_A1(PG8_SA(0, 1), cA, vcur);
    if (wr == 1) PG8_BAR;
    PG8_WAIT_V(2); PG8_BAR;
    PG8_STAGE(PG8_SB(1, 0), cB + kstep, voffB[0]); PG8_STAGE(PG8_SA(1, 0), cA + kstep, vcur[0]); PG8_STAGE_B1(PG8_SB(1, 1), cB + kstep); PG8_STAGE_A1(PG8_SA(1, 1), cA + kstep, vcur);
    PG8_WAIT_V(0); PG8_BAR;
    for (;;) {
        const bool has_next = S.next(ui + 1, nxt);
        const char* nA = GATHER ? (const char*)g.A : (has_next ? (const char*)g.A + (size_t)nxt.pm * tstep : cA); const char* nB = has_next ? (const char*)g.Bt + (size_t)nxt.pb * tstep : cB;
#pragma unroll
        for (int _h = 0; _h < 2; ++_h)
#pragma unroll
            for (int _i = 0; _i < 2; ++_i) vnxt[_h][_i] = vcur[_h][_i];
#define PG8_TRIP(FIRST, t_) do { const int t = (t_); const bool last = (t == nt - 2); \
            if constexpr (GATHER) { if (last && has_next) { PG8_AOFFS(vnxt, nxt); } }     \
            const char* a1 = cA + (size_t)(t + 1) * kstep; \
            const char* a2 = last ? nA : cA + (size_t)(t + 2) * kstep; const char* b2 = last ? nB : cB + (size_t)(t + 2) * kstep; \
            const char* a3 = a2 + kstep; const char* b3 = b2 + kstep; \
            unsigned s0[2], s1[2]; \
            _Pragma("unroll") for (int _i = 0; _i < 2; ++_i) { if constexpr (GATHER) { s0[_i] = last ? vnxt[0][_i] : vcur[0][_i]; s1[_i] = last ? vnxt[1][_i] : vcur[1][_i]; } else { s0[_i] = vcur[0][_i]; s1[_i] = vcur[1][_i]; } } \
              \
            PG8_LDB(B0, 0, 0); PG8_LDB(B1, 0, 1); PG8_SCHED; PG8_LDA(At, 0, 0); if constexpr (!(FIRST)) { PG8_STAGE_A1(PG8_SA(1, 1), a1, vcur); PG8_WAIT_V(8); } \
            PG8_WAIT_L(0); PG8_BAR; PG8_MMA(FIRST, 0, 0, At, B0); PG8_MMA(FIRST, 0, 1, At, B1); PG8_BAR; PG8_SCHED; \
              \
            PG8_LDA(At, 0, 1); PG8_STAGE(PG8_SB(0, 0), b2, voffB[0]); PG8_STAGE_B1(PG8_SB(0, 1), b2); PG8_STAGE(PG8_SA(0, 0), a2, s0); \
            if constexpr (FIRST) PG8_WAIT_VN(8 + Epi::NST); else PG8_WAIT_V(8); \
            PG8_WAIT_L(0); PG8_BAR; PG8_MMA(FIRST, 1, 0, At, B0); PG8_MMA(FIRST, 1, 1, At, B1); PG8_BAR; PG8_SCHED; \
              \
            PG8_LDB(B0, 1, 0); PG8_LDB(B1, 1, 1); PG8_SCHED; PG8_LDA(At, 1, 0); if constexpr (GATHER) PG8_STAGE(PG8_SA(0, 1), a2, s1); else PG8_STAGE(PG8_SA(0, 1), (a2) + hstep, s0); \
            if constexpr (FIRST) PG8_WAIT_VN(8 + Epi::NST); else PG8_WAIT_V(8); \
            PG8_WAIT_L(0); PG8_BAR; PG8_MMA(false, 0, 0, At, B0); PG8_MMA(false, 0, 1, At, B1); PG8_BAR; PG8_SCHED; \
              \
            PG8_LDA(At, 1, 1); PG8_STAGE(PG8_SB(1, 0), b3, voffB[0]); PG8_STAGE_B1(PG8_SB(1, 1), b3); PG8_STAGE(PG8_SA(1, 0), a3, s0); \
            PG8_WAIT_V(8); PG8_WAIT_L(0); PG8_BAR; PG8_MMA(false, 1, 0, At, B0); PG8_MMA(false, 1, 1, At, B1); PG8_BAR; PG8_SCHED; } while (0)
        PG8_TRIP(true, 0);
        for (int tt = 2; tt < nt; tt += 2) PG8_TRIP(false, tt);
        if constexpr (FP8) asm volatile("s_nop 15\n\ts_nop 15" ::: "memory");
        if constexpr (ALIGN_EPI) { if (wr == 0) PG8_BAR; }
        static_assert(ALIGN_EPI, "the pre-epilogue piece below needs both halves past their last LDS reads");
        if (has_next) { if constexpr (GATHER) PG8_STAGE(PG8_SA(1, 1), nA + kstep, vnxt[1]); else PG8_STAGE(PG8_SA(1, 1), nA + kstep + hstep, vcur[0]); }
        E(acc, cur, wr, wc, fr, fq);
        if (!has_next) break;
        cur = nxt; cA = nA; cB = nB; ++ui;
#pragma unroll
        for (int _h = 0; _h < 2; ++_h)
#pragma unroll
            for (int _i = 0; _i < 2; ++_i) vcur[_h][_i] = vnxt[_h][_i];
        if constexpr (ALIGN_EPI) { if (wr == 1) PG8_BAR; }
    }
    PG8_WAIT_V(0);
    if constexpr (!ALIGN_EPI) { if (wr == 0) PG8_BAR; }
    PG8_BAR;
#undef PG8_SA
#undef PG8_SB
#undef PG8_STAGE
#undef PG8_LDA
#undef PG8_STAGE_A1
#undef PG8_STAGE_B1
#undef PG8_LDB
#undef PG8_MMA
#undef PG8_CAT8
#undef PG8_WAIT_V
#undef PG8_WAIT_VN
#undef PG8_WAIT_L
#undef PG8_BAR
#undef PG8_SCHED
#undef PG8_AOFFS
#undef PG8_TRIP
}
}
#ifndef FOX_DOUBLE
#define FOX_DOUBLE 0
#endif
namespace fox {
using bf16 = __hip_bfloat16;
typedef short bf16x8 __attribute__((ext_vector_type(8)));
typedef short s16x4 __attribute__((ext_vector_type(4)));
typedef float f32x16 __attribute__((ext_vector_type(16)));
typedef float f32x4 __attribute__((ext_vector_type(4)));
typedef unsigned u32x4 __attribute__((ext_vector_type(4)));
constexpr int D = 128, LDQ = 2048, SEQ = 4096, NH = 16, NB = 4;
constexpr int NW = 8, QBLK = 32, KVBLK = 64, QB = NW * QBLK;
constexpr int SHM_V = KVBLK * D * 2, SHM_K = KVBLK * D * 2;
constexpr int OFF_WS = 2 * SHM_V + 2 * SHM_K, OFF_CB = OFF_WS + NW * 64 * 4, LDS_BYTES = OFF_CB + 2 * 64 * 4;
constexpr float THRL = 11.5f;

#define KSWZ(row, colB) ((row) * 256 + ((colB) ^ (((row) & 7) << 4)))
#define SBAR() __builtin_amdgcn_sched_barrier(0)
__device__ __forceinline__ int v_st(int k, int c) { const int kk = (k & ~0xC) | ((k & 4) << 1) | ((k & 8) >> 1); return ((kk >> 3) * 4 + (c >> 5)) * 512 + ((kk & 7) * 32 + (c & 31)) * 2; }
__device__ __forceinline__ int v_rd_base(int lane) { return ((lane & 3) << 3) | (((lane >> 2) & 3) << 6) | (((lane >> 4) & 1) << 5) | (((lane >> 5) & 1) << 8); }
constexpr int v_rd_off(int d0, int ks, int half) { return d0 * 512 + ks * 4096 + half * 2048; }
__device__ __forceinline__ int crow(int r, int hi) { return (r & 3) + 8 * (r >> 2) + 4 * hi; }
__device__ __forceinline__ unsigned cvtpk(float lo, float hi) {
    unsigned r; asm volatile("v_cvt_pk_bf16_f32 %0, %1, %2" : "=v"(r) : "v"(lo), "v"(hi)); return r;
}
__device__ __forceinline__ bf16x8 load8(const bf16* p) { return *reinterpret_cast<const bf16x8*>(p); }
__device__ __forceinline__ void mask_tile(f32x16& p0, f32x16& p1, int dq) {
    const float NEG = -__builtin_inff();
#pragma unroll
    for (int r = 0; r < 16; ++r) {
        const int c = (r & 3) + 8 * (r >> 2);
        if (dq - c < 0) p0[r] = NEG;
        if (dq - c - 32 < 0) p1[r] = NEG;
    }
}
__device__ __forceinline__ void partialSM(f32x16& p0, f32x16& p1, float& m_reg, float& mn, float& alpha) {
    float pmax = p0[0]; for (int r = 1; r < 16; ++r) pmax = fmaxf(pmax, p0[r]); for (int r = 0; r < 16; ++r) pmax = fmaxf(pmax, p1[r]);
    { auto rr = __builtin_amdgcn_permlane32_swap(__float_as_uint(pmax), __float_as_uint(pmax), false, false);
      pmax = fmaxf(__uint_as_float(rr[0]), __uint_as_float(rr[1])); }
    if (__builtin_expect(__all((pmax - m_reg) <= THRL), 1)) { mn = m_reg; alpha = 1.f; }
    else { mn = fmaxf(m_reg, pmax); alpha = __builtin_amdgcn_exp2f(m_reg - mn); m_reg = mn; }
    for (int r = 0; r < 16; ++r) p0[r] = p0[r] - mn; for (int r = 0; r < 16; ++r) p1[r] = p1[r] - mn;
    for (int r = 0; r < 16; ++r) p0[r] = __builtin_amdgcn_exp2f(p0[r]);
}
__device__ __forceinline__ void finishSM(f32x16& p0, f32x16& p1, float alpha, float& l_reg, bf16x8& pa0, bf16x8& pa1, bf16x8& pa2, bf16x8& pa3) {
    for (int r = 0; r < 16; ++r) p1[r] = __builtin_amdgcn_exp2f(p1[r]);
    float ps = 0; for (int r = 0; r < 16; ++r) ps += p0[r]; for (int r = 0; r < 16; ++r) ps += p1[r];
    { auto rr = __builtin_amdgcn_permlane32_swap(__float_as_uint(ps), __float_as_uint(ps), false, false);
      ps = __uint_as_float(rr[0]) + __uint_as_float(rr[1]); }
    l_reg = l_reg * alpha + ps;
#define PK4(P, B_, OUT) do { unsigned a0 = cvtpk(P[B_+0], P[B_+1]), a1 = cvtpk(P[B_+2], P[B_+3]);                          \
        unsigned b0 = cvtpk(P[B_+4], P[B_+5]), b1 = cvtpk(P[B_+6], P[B_+7]);                                             \
        auto r0 = __builtin_amdgcn_permlane32_swap(a0, b0, false, false); auto r1 = __builtin_amdgcn_permlane32_swap(a1, b1, false, false); \
        u32x4 w = {r0[0], r1[0], r0[1], r1[1]}; OUT = *reinterpret_cast<bf16x8*>(&w); } while (0)
    PK4(p0, 0, pa0); PK4(p0, 8, pa1); PK4(p1, 0, pa2); PK4(p1, 8, pa3);
#undef PK4
}
template <int KB>
__device__ __forceinline__ void qkt(f32x16& p0, f32x16& p1, const char* K_lds, const float* cbl, int r32, int hi, const bf16x8* qr) {
    const float* cb = cbl + KB * 64 + 4 * hi;
#pragma unroll
    for (int g = 0; g < 4; ++g) { const f32x4 a = *(const f32x4*)(cb + 8 * g), b = *(const f32x4*)(cb + 32 + 8 * g);
        p0[4 * g + 0] = a[0]; p0[4 * g + 1] = a[1]; p0[4 * g + 2] = a[2]; p0[4 * g + 3] = a[3];
        p1[4 * g + 0] = b[0]; p1[4 * g + 1] = b[1]; p1[4 * g + 2] = b[2]; p1[4 * g + 3] = b[3]; }
    const char* kb[4];
#pragma unroll
    for (int dd = 0; dd < 4; ++dd) kb[dd] = K_lds + KB * SHM_K + KSWZ(r32, (dd * 16 + hi * 8) * 2);
#pragma unroll
    for (int d0 = 0; d0 < 8; ++d0) { const char* a = kb[d0 & 3] + (d0 >> 2) * 128;
        bf16x8 b0 = *reinterpret_cast<const bf16x8*>(a);
        bf16x8 b1 = *reinterpret_cast<const bf16x8*>(a + 32 * 256);
        p0 = __builtin_amdgcn_mfma_f32_32x32x16_bf16(b0, qr[d0], p0, 0, 0, 0);
        p1 = __builtin_amdgcn_mfma_f32_32x32x16_bf16(b1, qr[d0], p1, 0, 0, 0); }
}
template <int VB>
__device__ __forceinline__ void pv_tile(f32x16* o, int vb0, bf16x8 pa0, bf16x8 pa1, bf16x8 pa2, bf16x8 pa3) {
#define TRRD(dst, off) asm volatile("ds_read_b64_tr_b16 %0, %1 offset:%2" : "=&v"(dst) : "v"(vb0), "i"(off) : "memory")
#define PV_D0(d0) do { s16x4 l0, l1, l2, l3, h0, h1, h2, h3; constexpr int b_ = VB * SHM_V + v_rd_off(d0, 0, 0);     \
        TRRD(l0, b_); TRRD(h0, b_ + 2048); TRRD(l1, b_ + 4096); TRRD(h1, b_ + 6144); TRRD(l2, b_ + 8192); TRRD(h2, b_ + 10240); TRRD(l3, b_ + 12288); TRRD(h3, b_ + 14336); \
        asm volatile("s_waitcnt lgkmcnt(0)" ::: "memory"); SBAR();                                                              \
        o[d0] = __builtin_amdgcn_mfma_f32_32x32x16_bf16(pa0, (bf16x8){l0[0], l0[1], l0[2], l0[3], h0[0], h0[1], h0[2], h0[3]}, o[d0], 0, 0, 0);   \
        o[d0] = __builtin_amdgcn_mfma_f32_32x32x16_bf16(pa1, (bf16x8){l1[0], l1[1], l1[2], l1[3], h1[0], h1[1], h1[2], h1[3]}, o[d0], 0, 0, 0);   \
        o[d0] = __builtin_amdgcn_mfma_f32_32x32x16_bf16(pa2, (bf16x8){l2[0], l2[1], l2[2], l2[3], h2[0], h2[1], h2[2], h2[3]}, o[d0], 0, 0, 0);   \
        o[d0] = __builtin_amdgcn_mfma_f32_32x32x16_bf16(pa3, (bf16x8){l3[0], l3[1], l3[2], l3[3], h3[0], h3[1], h3[2], h3[3]}, o[d0], 0, 0, 0); } while (0)
    PV_D0(0); PV_D0(1); PV_D0(2); PV_D0(3);
#undef PV_D0
#undef TRRD
}

struct BlockRef { const bf16* Q; const bf16* K; const bf16* V; bf16* O; const float* C; int P0, jlo; };
struct Seam { bf16x8 qr[8]; bf16x8 st_v0, st_v1, st_k0, st_k1; float st_c; };
#define ROW(p, k0, rr) ((p) + (size_t)((k0) + (rr)) * LDQ + sc)
#define VMW() asm volatile("s_waitcnt vmcnt(0)" ::: "memory")
#define VMWN(n) asm volatile("s_waitcnt vmcnt(%0)" :: "i"(n) : "memory")
#define SLOAD_H(Kp, Vp, Cp, cr, k0) do { const char* kb_ = (const char*)(Kp) + (size_t)(k0) * (LDQ * 2); const char* vb_ = (const char*)(Vp) + (size_t)(k0) * (LDQ * 2);     \
                         int u_ = threadIdx.x; asm volatile("" : "+v"(u_)); const unsigned voffA = (unsigned)((u_ >> 4) * LDQ + (u_ & 15) * 8) * 2u, voffB = voffA + 32u * LDQ * 2u; \
                         S.st_v0 = *(const bf16x8*)(vb_ + voffA); S.st_v1 = *(const bf16x8*)(vb_ + voffB);              \
                         S.st_k0 = *(const bf16x8*)(kb_ + voffA); S.st_k1 = *(const bf16x8*)(kb_ + voffB); S.st_c = (Cp)[(k0) + (u_ & 63)] - (cr); } while (0)
#define SWRITE_HK(bf) do { int t_ = threadIdx.x; asm volatile("" : "+v"(t_)); const int sr_ = t_ >> 4, sc_ = (t_ & 15) * 8, kws_ = KSWZ(sr_, sc_ * 2); \
        *(bf16x8*)(K_lds + (bf) * SHM_K + kws_) = S.st_k0; *(bf16x8*)(K_lds + (bf) * SHM_K + kws_ + 32 * 256) = S.st_k1; cbl[(bf) * 64 + (t_ & 63)] = S.st_c; } while (0)
#define SWRITE_HV(bf) do { int t_ = threadIdx.x; asm volatile("" : "+v"(t_)); const int sr_ = t_ >> 4, sc_ = (t_ & 15) * 8; \
        *(bf16x8*)(V_lds + (bf) * SHM_V + v_st(sr_, sc_)) = S.st_v0; *(bf16x8*)(V_lds + (bf) * SHM_V + v_st(32 + sr_, sc_)) = S.st_v1; } while (0)
#define SWRITE_H(bf) do { SWRITE_HV(bf); SWRITE_HK(bf); } while (0)
__device__ __forceinline__ void fox_prime(const BlockRef& cur, char* lds, Seam& S) {
    const int tid = threadIdx.x, wid = __builtin_amdgcn_readfirstlane(tid >> 6), lane = tid & 63, r32 = lane & 31, hi = lane >> 5;
    const int sr = tid >> 4, sc = (tid & 15) * 8, kws = KSWZ(sr, sc * 2); char* K_lds = lds + 2 * SHM_V; float* cbl = (float*)(lds + OFF_CB);
    const float cref = cur.C[cur.P0 + QB - 1];
    for (int d0 = 0; d0 < 8; ++d0) S.qr[d0] = load8(cur.Q + (size_t)(wid * QBLK + r32) * LDQ + d0 * 16 + hi * 8);
    SLOAD_H(cur.K, cur.V, cur.C, cref, cur.jlo * KVBLK); VMW(); SWRITE_HK(0);
    __syncthreads();
}
__device__ __forceinline__ void fox_block(const BlockRef& cur, const BlockRef& nxt, char* lds, Seam& S) {
    const int tid = threadIdx.x, wid = __builtin_amdgcn_readfirstlane(tid >> 6), lane = tid & 63, r32 = lane & 31, hi = lane >> 5;
    const int j_lo = cur.jlo, NT = (cur.P0 + QB - 1) / KVBLK + 1 - j_lo;
    const int qlo = cur.P0 + wid * QBLK, qm = qlo + r32 - 4 * hi;
    char* V_lds = lds; char* K_lds = lds + 2 * SHM_V; float* cbl = (float*)(lds + OFF_CB);
    float* ws = (float*)(lds + OFF_WS) + wid * 64; float* li_l = ws, * al_l = ws + 32;
    float l_reg = 0; f32x16 o[4] = {};
    const int sr = tid >> 4, sc = (tid & 15) * 8, vst0 = v_st(sr, sc), vst1 = v_st(32 + sr, sc), kws = KSWZ(sr, sc * 2);
    const int vb0 = (int)(uintptr_t)V_lds + v_rd_base(lane);
    const bf16* Kh = cur.K; const bf16* Vh = cur.V; const float* Ch = cur.C;
    const float cref = Ch[cur.P0 + QB - 1], crefn = nxt.C[nxt.P0 + QB - 1];
    float m_reg = Ch[qlo + r32] - cref - 4.0f;
#define RESC(a) do { if (__any((a) < 1.f)) { if (hi == 0) al_l[r32] = (a); asm volatile("s_waitcnt lgkmcnt(0)" ::: "memory");              \
                     for (int d_ = 0; d_ < 4; ++d_) for (int r = 0; r < 16; ++r) o[d_][r] *= al_l[crow(r, hi)]; } } while (0)
#define KBASE(t) ((j_lo + (t)) * KVBLK)
#define MASKT(P0_, P1_, t) do { const int kb_ = KBASE(t); if (kb_ + KVBLK - 1 > qlo) mask_tile(P0_, P1_, qm - kb_); } while (0)
    constexpr int NQL = 8;
#define SEAM_K0() do { VMWN(NQL); SWRITE_HK(0); SBAR(); } while (0)
    f32x16 pA0, pA1, pB0, pB1; float mnA, mnB, alA, alB; bf16x8 pa0, pa1, pa2, pa3;
    SWRITE_HV(0); SBAR();
    if (NT > 1) { SLOAD_H(Kh, Vh, Ch, cref, KBASE(1)); }
    SBAR(); qkt<0>(pA0, pA1, K_lds, cbl, r32, hi, S.qr);
    MASKT(pA0, pA1, 0); partialSM(pA0, pA1, m_reg, mnA, alA);
    if (NT > 1) { VMW(); SWRITE_H(1); }
    __syncthreads();
#define HALF_STEP(PX0, PX1, mnX, alX, PY0, PY1, alY, t, KB, VB, SB) do {                                                      \
        SBAR(); qkt<KB>(PX0, PX1, K_lds, cbl, r32, hi, S.qr);                                                                 \
        finishSM(PY0, PY1, alY, l_reg, pa0, pa1, pa2, pa3); SBAR();                                                           \
        if ((t) + 1 < NT) { SLOAD_H(Kh, Vh, Ch, cref, KBASE((t) + 1)); SBAR(); }                                              \
        pv_tile<VB>(o, vb0, pa0, pa1, pa2, pa3); MASKT(PX0, PX1, (t)); partialSM(PX0, PX1, m_reg, mnX, alX);                  \
        __syncthreads();                                                                                                      \
        if ((t) + 1 < NT) { VMW(); SWRITE_H(SB); }                                                                            \
        RESC(alX); __syncthreads(); } while (0)
    for (int t = 1; t + 1 < NT; t += 2) {
        HALF_STEP(pB0, pB1, mnB, alB, pA0, pA1, alA, t, 1, 0, 0);
        HALF_STEP(pA0, pA1, mnA, alA, pB0, pB1, alB, t + 1, 0, 1, 1);
    }
    const bool even = (NT & 1) == 0;
    if (even) { SBAR(); qkt<1>(pB0, pB1, K_lds, cbl, r32, hi, S.qr); SBAR(); }
    SLOAD_H(nxt.K, nxt.V, nxt.C, crefn, nxt.jlo * KVBLK); SBAR();
#pragma unroll
    for (int d0 = 0; d0 < 8; ++d0) S.qr[d0] = load8(nxt.Q + (size_t)(wid * QBLK + r32) * LDQ + d0 * 16 + hi * 8);
    SBAR();
    finishSM(pA0, pA1, alA, l_reg, pa0, pa1, pa2, pa3); SBAR();
    pv_tile<0>(o, vb0, pa0, pa1, pa2, pa3);
    if (even) { MASKT(pB0, pB1, NT - 1); partialSM(pB0, pB1, m_reg, mnB, alB); __syncthreads(); RESC(alB);
        finishSM(pB0, pB1, alB, l_reg, pa0, pa1, pa2, pa3); SBAR(); pv_tile<1>(o, vb0, pa0, pa1, pa2, pa3); }
    SBAR(); SEAM_K0();
    if (hi == 0) li_l[r32] = l_reg; asm volatile("s_waitcnt lgkmcnt(0)" ::: "memory");
    float rli[16];
#pragma unroll
    for (int r = 0; r < 16; ++r) rli[r] = __builtin_amdgcn_rcpf(li_l[crow(r, hi)]);
    bf16* Ow = cur.O + (size_t)(wid * QBLK) * LDQ;
#pragma unroll
    for (int r = 0; r < 16; ++r) { const int orow = crow(r, hi);
#pragma unroll
        for (int d0 = 0; d0 < 4; ++d0) { const float v = o[d0][r] * rli[r];
            const float vn = __shfl_xor(v, 1);
            if ((r32 & 1) == 0) *(unsigned*)(Ow + (size_t)orow * LDQ + d0 * 32 + r32) = cvtpk(v, vn); } }
    __syncthreads();
#undef RESC
#undef KBASE
#undef MASKT
#undef SEAM_K0
#undef HALF_STEP
}
#undef ROW
#undef VMW
#undef VMWN
#undef SLOAD_H
#undef SWRITE_HK
#undef SWRITE_HV
#undef SWRITE_H
#undef KSWZ
#undef SBAR

__device__ __forceinline__ int dq(char* lds, unsigned* ctr) {
    volatile __attribute__((address_space(3))) int* sq = (volatile __attribute__((address_space(3))) int*)(lds + LDS_BYTES);
    __syncthreads();
    if (threadIdx.x == 0) sq[0] = (int)__hip_atomic_fetch_add(ctr, 1u, __ATOMIC_RELAXED, __HIP_MEMORY_SCOPE_AGENT);
    __syncthreads();
    return __builtin_amdgcn_readfirstlane(sq[0]);
}
__device__ __forceinline__ BlockRef ref(int L, const bf16* Q, const bf16* K, const bf16* V, bf16* O, const float* CB, const int* jtab) {
    L &= 1023; const int bh = L & 63, qb = 15 - (L >> 6), b = bh >> 4, h = bh & 15; const size_t rowb = (size_t)b * SEQ;
    BlockRef r; r.Q = Q + (rowb + (size_t)qb * QB) * LDQ + h * D; r.O = O + (rowb + (size_t)qb * QB) * LDQ + h * D;
    r.K = K + rowb * LDQ + h * D; r.V = V + rowb * LDQ + h * D; r.C = CB + (size_t)bh * SEQ; r.P0 = qb * QB; r.jlo = __builtin_amdgcn_readfirstlane(jtab[L]); return r;
}
__device__ __forceinline__ void fox_jlo_item(char* lds, int L, const float* CB, const float* qn2, const float* kn2, int* jtab) {
    const int tid = threadIdx.x, lane = tid & 63, wid = tid >> 6;
    volatile __attribute__((address_space(3))) float* sf = (volatile __attribute__((address_space(3))) float*)(lds + 64);
    const int bh = L & 63, qb = 15 - (L >> 6), P0 = qb * QB;
    float qm = 0.f, km = 0.f;
    if (tid < QB) qm = qn2[(size_t)bh * SEQ + P0 + tid];
    for (int j = tid; j < P0 + QB; j += NW * 64) km = fmaxf(km, kn2[(size_t)bh * SEQ + j]);
#pragma unroll
    for (int o = 1; o < 64; o <<= 1) { qm = fmaxf(qm, __shfl_xor(qm, o)); km = fmaxf(km, __shfl_xor(km, o)); }
    __syncthreads();
    if (lane == 0) { sf[wid] = qm; sf[8 + wid] = km; }
    __syncthreads();
    if (tid < 64) {
        float q2 = 0.f, k2 = 0.f;
#pragma unroll
        for (int w = 0; w < 8; ++w) { q2 = fmaxf(q2, sf[w]); k2 = fmaxf(k2, sf[8 + w]); }
        const float thr = 2.04f * sqrtf(q2 * k2) + 40.f;
        const float* C = CB + (size_t)bh * SEQ; const int tmax = P0 / KVBLK;
        const bool keep = (lane >= tmax) || (C[64 * lane + 63] - C[P0] >= -thr);
        const unsigned long long m = __ballot(keep);
        if (tid == 0) jtab[L] = __builtin_ctzll(m);
    }
}
__device__ __forceinline__ void fox_phase(char* lds, const bf16* Q, const bf16* K, const bf16* V, bf16* O, const float* CB, unsigned* ctr, const int* jtab) {
    constexpr int total = NB * NH * 16 * (FOX_DOUBLE ? 2 : 1);
    int L = dq(lds, ctr); if (L >= total) return;
    int Ln = dq(lds, ctr);
    BlockRef cur = ref(L, Q, K, V, O, CB, jtab);
    Seam S;
    fox_prime(cur, lds, S);
    for (;;) {
        const bool last = Ln >= total;
        const BlockRef nxt = last ? cur : ref(Ln, Q, K, V, O, CB, jtab);
        fox_block(cur, nxt, lds, S);
        if (last) break;
        cur = nxt; L = Ln; Ln = dq(lds, ctr);
    }
}
}
namespace swa {
using bf16 = __hip_bfloat16;
typedef short bf16x8 __attribute__((ext_vector_type(8)));
typedef short s16x4 __attribute__((ext_vector_type(4)));
typedef float f32x16 __attribute__((ext_vector_type(16)));
typedef unsigned u32x4 __attribute__((ext_vector_type(4)));
constexpr int SEQ = 4096, LDQ = 2048, LDKV = 256, QT = 32, NKT = 5, KEYS = 160, VROW = 144, VBUF = KEYS * VROW, NUNITS = 4 * 4 * (SEQ / QT);
constexpr int OFF_WS = 2 * VBUF, LDS_BYTES = OFF_WS + 8 * 32 * 4;
__device__ __forceinline__ int crow(int r, int hi) { return (r & 3) + 8 * (r >> 2) + 4 * hi; }
__device__ __forceinline__ unsigned cvtpk(float lo, float hi) { unsigned r; asm volatile("v_cvt_pk_bf16_f32 %0, %1, %2" : "=v"(r) : "v"(lo), "v"(hi)); return r; }
struct UnitRef { int b, kvh, q0; };
__device__ __forceinline__ UnitRef decode(int u) { UnitRef r; r.b = u >> 9; r.kvh = (u >> 7) & 3; r.q0 = (u & 127) * QT; return r; }

__device__ __forceinline__ void swa_phase(char* lds, const bf16* Q, const bf16* Kc, const bf16* Vc, bf16* O, const float* sinks, int blk, int nblk) {
    const int tid = threadIdx.x, wid = __builtin_amdgcn_readfirstlane(tid >> 6), lane = tid & 63, r32 = lane & 31, hi = lane >> 5;
    float* wsf = (float*)(lds + OFF_WS) + wid * 32;
    int u = blk; if (u >= NUNITS) return;
    u32x4 st0, st1, st2;
#define V_LOAD(uu) do { const UnitRef R_ = decode(uu); const bf16* vb_ = Vc + (size_t)R_.b * SEQ * LDKV + R_.kvh * 64; \
        { const int c = tid, kk = c >> 3, ch = c & 7; int pos = R_.q0 - 128 + kk; pos = pos < 0 ? 0 : pos; st0 = *(const u32x4*)(vb_ + (size_t)pos * LDKV + ch * 8); } \
        { const int c = tid + 512, kk = c >> 3, ch = c & 7; int pos = R_.q0 - 128 + kk; pos = pos < 0 ? 0 : pos; st1 = *(const u32x4*)(vb_ + (size_t)pos * LDKV + ch * 8); } \
        if (tid < 256) { const int c = tid + 1024, kk = c >> 3, ch = c & 7; int pos = R_.q0 - 128 + kk; pos = pos < 0 ? 0 : pos; st2 = *(const u32x4*)(vb_ + (size_t)pos * LDKV + ch * 8); } } while (0)
#define V_WRITE(bufp) do { { const int c = tid; *(u32x4*)((bufp) + (c >> 3) * VROW + (c & 7) * 16) = st0; } \
        { const int c = tid + 512; *(u32x4*)((bufp) + (c >> 3) * VROW + (c & 7) * 16) = st1; } \
        if (tid < 256) { const int c = tid + 1024; *(u32x4*)((bufp) + (c >> 3) * VROW + (c & 7) * 16) = st2; } } while (0)
    V_LOAD(u); V_WRITE(lds);
    __syncthreads();
    int buf = 0;
    const int grp = lane >> 4, qq = (lane & 15) >> 2, pp = lane & 3;
    const int vrd = (8 * (grp >> 1) + qq) * VROW + (16 * (grp & 1) + 4 * pp) * 2;
    for (;;) {
        const int un = u + nblk; const bool has_next = un < NUNITS;
        if (has_next) V_LOAD(un);
        const UnitRef R = decode(u);
        const int h = R.kvh * 8 + wid; const size_t rowb = (size_t)R.b * SEQ;
        const float sink2 = sinks[h] * 1.4426950408889634f;
        bf16x8 qr[4];
        { const bf16* qp = Q + (rowb + R.q0 + r32) * LDQ + h * 64 + hi * 8;
#pragma unroll
          for (int d0 = 0; d0 < 4; ++d0) qr[d0] = *(const bf16x8*)(qp + d0 * 16); }
        f32x16 p[NKT];
#pragma unroll
        for (int j = 0; j < NKT; ++j) {
            int pos = R.q0 - 128 + 32 * j + r32; pos = pos < 0 ? 0 : pos;
            const bf16* kp = Kc + (rowb + pos) * LDKV + R.kvh * 64 + hi * 8;
            bf16x8 kf[4];
#pragma unroll
            for (int d0 = 0; d0 < 4; ++d0) kf[d0] = *(const bf16x8*)(kp + d0 * 16);
            f32x16 a = {};
#pragma unroll
            for (int d0 = 0; d0 < 4; ++d0) a = __builtin_amdgcn_mfma_f32_32x32x16_bf16(kf[d0], qr[d0], a, 0, 0, 0);
            p[j] = a;
        }
        { const int lo = (r32 + 1) > (128 - R.q0) ? (r32 + 1) : (128 - R.q0); const unsigned span = (unsigned)(r32 + 128 - lo); const float NEG = -__builtin_inff();
#pragma unroll
          for (int j = 0; j < NKT; ++j)
#pragma unroll
              for (int r = 0; r < 16; ++r) { const int kk = 32 * j + (r & 3) + 8 * (r >> 2) + 4 * hi; if ((unsigned)(kk - lo) > span) p[j][r] = NEG; } }
        float mx = sink2;
#pragma unroll
        for (int j = 0; j < NKT; ++j)
#pragma unroll
            for (int r = 0; r < 16; ++r) mx = fmaxf(mx, p[j][r]);
        { auto rr = __builtin_amdgcn_permlane32_swap(__float_as_uint(mx), __float_as_uint(mx), false, false); mx = fmaxf(__uint_as_float(rr[0]), __uint_as_float(rr[1])); }
        float ps = 0.f;
#pragma unroll
        for (int j = 0; j < NKT; ++j)
#pragma unroll
            for (int r = 0; r < 16; ++r) { const float e = __builtin_amdgcn_exp2f(p[j][r] - mx); p[j][r] = e; ps += e; }
        { auto rr = __builtin_amdgcn_permlane32_swap(__float_as_uint(ps), __float_as_uint(ps), false, false); ps = __uint_as_float(rr[0]) + __uint_as_float(rr[1]); }
        const float l = ps + __builtin_amdgcn_exp2f(sink2 - mx);
        bf16x8 pa[2 * NKT];
#define PK4(P, B_, OUT) do { unsigned a0 = cvtpk(P[B_+0], P[B_+1]), a1 = cvtpk(P[B_+2], P[B_+3]);                          \
        unsigned b0 = cvtpk(P[B_+4], P[B_+5]), b1 = cvtpk(P[B_+6], P[B_+7]);                                             \
        auto r0 = __builtin_amdgcn_permlane32_swap(a0, b0, false, false); auto r1 = __builtin_amdgcn_permlane32_swap(a1, b1, false, false); \
        u32x4 w = {r0[0], r1[0], r0[1], r1[1]}; OUT = *reinterpret_cast<bf16x8*>(&w); } while (0)
#pragma unroll
        for (int j = 0; j < NKT; ++j) { PK4(p[j], 0, pa[2 * j]); PK4(p[j], 8, pa[2 * j + 1]); }
#undef PK4
        f32x16 o[2] = {};
        const int vb = (int)(uintptr_t)(lds + buf * VBUF) + vrd;
#define TRRD(dst, off) asm volatile("ds_read_b64_tr_b16 %0, %1 offset:%2" : "=&v"(dst) : "v"(vb), "i"(off) : "memory")
#pragma unroll
        for (int g = 0; g < 2 * NKT; ++g) {
            s16x4 l0, h0, l1, h1;
            TRRD(l0, g * 16 * VROW); TRRD(h0, g * 16 * VROW + 4 * VROW); TRRD(l1, g * 16 * VROW + 64); TRRD(h1, g * 16 * VROW + 4 * VROW + 64);
            asm volatile("s_waitcnt lgkmcnt(0)" ::: "memory"); __builtin_amdgcn_sched_barrier(0);
            o[0] = __builtin_amdgcn_mfma_f32_32x32x16_bf16(pa[g], (bf16x8){l0[0], l0[1], l0[2], l0[3], h0[0], h0[1], h0[2], h0[3]}, o[0], 0, 0, 0);
            o[1] = __builtin_amdgcn_mfma_f32_32x32x16_bf16(pa[g], (bf16x8){l1[0], l1[1], l1[2], l1[3], h1[0], h1[1], h1[2], h1[3]}, o[1], 0, 0, 0);
        }
#undef TRRD
        if (hi == 0) wsf[r32] = l;
        asm volatile("s_waitcnt lgkmcnt(0)" ::: "memory");
        bf16* Ow = O + (rowb + R.q0) * LDQ + h * 64;
#pragma unroll
        for (int r = 0; r < 16; ++r) { const int orow = crow(r, hi); const float rl = __builtin_amdgcn_rcpf(wsf[orow]);
#pragma unroll
            for (int d0 = 0; d0 < 2; ++d0) { const float v = o[d0][r] * rl; const float vn = __shfl_xor(v, 1);
                if ((r32 & 1) == 0) *(unsigned*)(Ow + (size_t)orow * LDQ + d0 * 32 + r32) = cvtpk(v, vn); } }
        if (has_next) V_WRITE(lds + (buf ^ 1) * VBUF);
        __syncthreads();
        if (!has_next) break;
        u = un; buf ^= 1;
    }
#undef V_LOAD
#undef V_WRITE
}
}
constexpr int NWAVES = 8;
#ifndef MK_PER_PHASE
#define MK_PER_PHASE 0
#endif
constexpr int N_PHASES = 18;
#ifndef FP8_MASK
#define FP8_MASK 3
#endif
constexpr float W8SCALE = 64.f;

constexpr int SEQ = 4096, NBATCH = 4, T = NBATCH * SEQ, D = 2048, NEXP = 64, TOPK = 8, EH = 512;
constexpr int NQKV_A = 3 * D, LDWIN = 3 * D + 16, NQKV_B = D + 512;
constexpr float ALPHA = 1.4142135623730951f, LN_EPS = 1e-5f;
constexpr float QSCALE_A = 0.08838834764831845f * 1.4426950408889634f;
constexpr float QSCALE_B = 0.125f * 1.4426950408889634f;
constexpr int MAXTILES = 640, MAXROWS = MAXTILES * 256;

constexpr size_t MiB = 1u << 20;
constexpr size_t WS_CTL = 0, CTL_ZERO_BYTES = 1 * MiB;
constexpr size_t WS_ROPE = 1 * MiB;
constexpr size_t WS_LOGF = 2 * MiB;
constexpr size_t WS_CB = 3 * MiB;
constexpr size_t WS_EIDX = 4 * MiB, WS_WTS = WS_EIDX + 512 * 1024, WS_SLOT = 5 * MiB, WS_TOK = WS_SLOT + 512 * 1024, WS_GATE = WS_TOK + 640 * 1024, WS_TILE = 7 * MiB;
constexpr size_t WS_NRM = 1360 * MiB;
constexpr size_t WS_GHIST = 8 * MiB;
constexpr size_t WS_GT = 9 * MiB;
constexpr size_t WS_WQKV_A = 12 * MiB, WS_WO_A = 36 * MiB, WS_WQKV_B = 44 * MiB, WS_WO_B = 54 * MiB;
constexpr size_t WS_WGU = 64 * MiB, WGU_L = 260 * MiB, WS_WD = 584 * MiB, WD_L = 130 * MiB;
constexpr size_t WS_XB = 848 * MiB, WS_QB = 912 * MiB, WS_KB = 976 * MiB, WS_VB = 1040 * MiB, WS_AO = 1104 * MiB;
constexpr size_t WS_Y1 = 1168 * MiB, WS_X1 = 1296 * MiB, WS_X1B = 1424 * MiB, WS_ACT = 1488 * MiB, WS_YP = 1648 * MiB, WS_X2 = 2288 * MiB, WS_END = 2416 * MiB;
static_assert(WS_GT + 2 * 64 * 2048 * 4 + 4096 <= WS_WQKV_A && WS_ACT + (size_t)MAXROWS * 512 * 2 <= WS_YP && WS_YP + (size_t)MAXROWS * 2048 * 2 <= WS_X2, "ws map");
constexpr int CW_TMO = 0;
constexpr int CW_CNT = 1024;
constexpr int CW_CUR = 2048;
constexpr int CW_CVTQ = 3648;
constexpr int CW_FOXQ = 3584;
constexpr int CW_NT = 3072;
constexpr int CW_BAR = 4096;

constexpr int RING_OFF = 0, RING_BYTES = 131072;
constexpr int LDSCTL_OFF = RING_BYTES, MISC_OFF = LDSCTL_OFF + 320;
constexpr int LDS_BYTES = 147456;
static_assert(MISC_OFF + 128 <= LDS_BYTES && fox::LDS_BYTES + 256 <= RING_BYTES && swa::LDS_BYTES <= RING_BYTES, "LDS map");

#define GAS __attribute__((address_space(1)))
#define LAS __attribute__((address_space(3)))
typedef unsigned short bf16;
typedef unsigned v4u __attribute__((ext_vector_type(4)));
typedef unsigned v2u __attribute__((ext_vector_type(2)));
typedef float f32x4 __attribute__((ext_vector_type(4)));
typedef GAS unsigned gu32;
#define RLX_AGENT __ATOMIC_RELAXED, __HIP_MEMORY_SCOPE_AGENT
#define LDS_WAIT() asm volatile("s_waitcnt lgkmcnt(0)" ::: "memory")
#define VM_WAIT() asm volatile("s_waitcnt vmcnt(0)" ::: "memory")
__device__ __forceinline__ unsigned f2bf(float f) { unsigned u = __builtin_bit_cast(unsigned, f); return (u + 0x7fffu + ((u >> 16) & 1u)) >> 16; }
__device__ __forceinline__ unsigned pk2(float lo, float hi) { return f2bf(lo) | (f2bf(hi) << 16); }
__device__ __forceinline__ float bf_lo(unsigned w) { return __builtin_bit_cast(float, w << 16); }
__device__ __forceinline__ float bf_hi(unsigned w) { return __builtin_bit_cast(float, w & 0xffff0000u); }

#define XB_TMO      128
#define XB_XCNT(j)  (256  + 64 * (j))
#define XB_XSUB(j)  (1280 + 64 * (j))
#define XB_XGEN(j)  (2304 + 64 * (j))
#define XB_TOP      3328
#define XB_TOPGEN   3392
#define XCD_BAR_WORDS 3456
#define XB_SPIN_CAP (1u << 18)

__device__ __forceinline__ unsigned xb_ld(unsigned* p)              { return __hip_atomic_load(p, __ATOMIC_RELAXED, __HIP_MEMORY_SCOPE_AGENT); }
__device__ __forceinline__ unsigned xb_add(unsigned* p, unsigned v) { return __hip_atomic_fetch_add(p, v, __ATOMIC_RELAXED, __HIP_MEMORY_SCOPE_AGENT); }
__device__ __forceinline__ unsigned xb_xcc_id() { return (unsigned)__builtin_amdgcn_s_getreg((3 << 11) | 20) & 0xFu; }
#define XB_SPIN(cond, bar) do { unsigned _sp = 0; while (cond) { __builtin_amdgcn_s_sleep(1); \
    if ((++_sp & 255u) == 0u) { if (xb_ld(&(bar)[XB_TMO])) break; if (_sp > XB_SPIN_CAP) { atomicAdd(&(bar)[XB_TMO], 1u); break; } } } } while (0)

struct XcdBarrier {
    unsigned* bar; unsigned x;
    volatile LAS unsigned* st;
};
__device__ __forceinline__ XcdBarrier xcd_barrier_post(unsigned* bar, volatile LAS unsigned* st) {
    XcdBarrier b; b.bar = bar; b.x = xb_xcc_id(); b.st = st;
    if (threadIdx.x == 0) (void)xb_add(&bar[XB_XCNT(b.x)], 1u);
    return b;
}
__device__ __forceinline__ void xcd_barrier_complete(unsigned* bar, unsigned x, unsigned& nloc, unsigned& nx) {
    const unsigned G = gridDim.x * gridDim.y * gridDim.z;
    unsigned sum, cnt, mine, sp = 0u;
    for (;;) {
        sum = 0u; cnt = 0u; mine = 0u;
#pragma unroll
        for (unsigned j = 0; j < 16; ++j) { const unsigned c = xb_ld(&bar[XB_XCNT(j)]); sum += c; cnt += (c > 0u) ? 1u : 0u; mine = (j == x) ? c : mine; }
        if (sum == G) break;
        __builtin_amdgcn_s_sleep(1);
        if ((++sp & 255u) == 0u) { if (xb_ld(&bar[XB_TMO])) break; if (sp > XB_SPIN_CAP) { atomicAdd(&bar[XB_TMO], 1u); break; } }
    }
    nloc = mine > 0u ? mine : 1u; nx = cnt > 0u ? cnt : 1u;
}
__device__ __forceinline__ void xcd_barrier(const XcdBarrier& b) {
    asm volatile("s_waitcnt vmcnt(0)" ::: "memory");
    __syncthreads();
    if (threadIdx.x == 0) {
        unsigned* bar = b.bar;
        __builtin_amdgcn_s_waitcnt(0);
        unsigned nloc = b.st[0], nx = b.st[1];
        if (nloc == 0u) { xcd_barrier_complete(bar, b.x, nloc, nx); b.st[0] = nloc; b.st[1] = nx; }
        const unsigned old = xb_add(&bar[XB_XSUB(b.x)], 1u);
        const unsigned gen = old / nloc;
        if (old + 1u == (gen + 1u) * nloc) {
            __builtin_amdgcn_fence(__ATOMIC_RELEASE, "agent");
            asm volatile("s_waitcnt vmcnt(0)" ::: "memory");
            const unsigned og = xb_add(&bar[XB_TOP], 1u);
            const unsigned tg = og / nx;
            if (og + 1u == (tg + 1u) * nx) xb_add(&bar[XB_TOPGEN], 1u);
            else XB_SPIN(xb_ld(&bar[XB_TOPGEN]) == tg, bar);
            __builtin_amdgcn_fence(__ATOMIC_ACQUIRE, "agent");
            xb_add(&bar[XB_XGEN(b.x)], 1u);
            asm volatile("s_waitcnt vmcnt(0)" ::: "memory");
        } else {
            XB_SPIN(xb_ld(&bar[XB_XGEN(b.x)]) == gen, bar);
            __builtin_amdgcn_fence(__ATOMIC_ACQUIRE, "agent");
            asm volatile("s_waitcnt vmcnt(0)" ::: "memory");
        }
    }
    __syncthreads();
}

struct Frame {
    LAS unsigned char* lds;
    unsigned char* ws;
    gu32* ctl;
    int tid, lane, wave;
    int vcu, G;
    const float* in[18]; float* out;
};
__device__ __forceinline__ float wave_sum(float v) {
#pragma unroll
    for (int o = 1; o < 64; o <<= 1) v += __shfl_xor(v, o);
    return v;
}

__device__ __forceinline__ int map_rope(int n) { const int t = n >> 8, w = n & 127, bj = (n >> 7) & 1; return 256 * t + 64 * (w >> 5) + 32 * bj + (w & 31); }
__device__ __forceinline__ int map_gu(int n) { const int t = n >> 8, w = n & 127, bj = (n >> 7) & 1; return 512 * bj + 128 * t + w; }

constexpr int CVT_I_QKVA = 16 * (NQKV_A / 32), CVT_I_WO = 16 * (D / 32), CVT_I_QKVB = 16 * (NQKV_B / 32), CVT_I_GU1 = 16 * 32, CVT_I_D1 = 4 * 64;
constexpr int CVT_O_WOA = CVT_I_QKVA, CVT_O_QKVB = CVT_O_WOA + CVT_I_WO, CVT_O_WOB = CVT_O_QKVB + CVT_I_QKVB, CVT_O_GU = CVT_O_WOB + CVT_I_WO, CVT_O_D = CVT_O_GU + 2 * 65 * CVT_I_GU1, CVT_NSUPER = CVT_O_D + 2 * 65 * CVT_I_D1;
constexpr int CVT_CH = 16, CVT_NCHUNK = (CVT_NSUPER - CVT_O_GU) / CVT_CH;
static_assert((CVT_NSUPER - CVT_O_GU) % CVT_CH == 0, "chunking");
template <bool DYN>
__device__ __forceinline__ void convert_weights(Frame& F, LAS float* scr, int limit = CVT_NCHUNK) {
    const int gw = F.vcu * NWAVES + F.wave, NGW = F.G * NWAVES, lane = F.lane;
    unsigned char* ws = F.ws;
    constexpr int O_WOA = CVT_O_WOA, O_QKVB = CVT_O_QKVB, O_WOB = CVT_O_WOB, O_GU = CVT_O_GU, O_D = CVT_O_D, I_GU1 = CVT_I_GU1, I_D1 = CVT_I_D1;
    constexpr int END = 0x7fffffff;
    struct TrD { const float* W; unsigned char* WT; int ldw, Kb, f8; };
    auto decode = [&](int step) -> TrD { TrD d; const int it = step >> 1, hf = step & 1;
        if (it < O_WOA) { const int nb = it % (NQKV_A / 32), kb = 2 * (it / (NQKV_A / 32)) + hf; d.W = F.in[1] + (size_t)(64 * kb) * LDWIN + 32 * nb; d.ldw = LDWIN; d.Kb = D * 2; d.f8 = 0; d.WT = ws + WS_WQKV_A + (size_t)(32 * nb) * (D * 2) + 128 * kb; }
        else if (it < O_QKVB) { const int r = it - O_WOA, nb = r % 64, kb = 2 * (r / 64) + hf; d.W = F.in[3] + (size_t)(64 * kb) * D + 32 * nb; d.ldw = D; d.Kb = D * 2; d.f8 = 0; d.WT = ws + WS_WO_A + (size_t)(32 * nb) * (D * 2) + 128 * kb; }
        else if (it < O_WOB) { const int r = it - O_QKVB, nb = r % (NQKV_B / 32), kb = 2 * (r / (NQKV_B / 32)) + hf, n = 32 * nb; d.Kb = D * 2; d.f8 = 0; d.WT = ws + WS_WQKV_B + (size_t)n * (D * 2) + 128 * kb;
            if (n < D) { d.W = F.in[5] + (size_t)(64 * kb) * D + map_rope(n); d.ldw = D; }
            else if (n < D + 256) { d.W = F.in[4] + (size_t)(64 * kb) * 512 + map_rope(n - D); d.ldw = 512; }
            else { d.W = F.in[4] + (size_t)(64 * kb) * 512 + (n - D); d.ldw = 512; } }
        else if (it < O_GU) { const int r = it - O_WOB, nb = r % 64, kb = 2 * (r / 64) + hf; d.W = F.in[7] + (size_t)(64 * kb) * D + 32 * nb; d.ldw = D; d.Kb = D * 2; d.f8 = 0; d.WT = ws + WS_WO_B + (size_t)(32 * nb) * (D * 2) + 128 * kb; }
        else if (it < O_D) { const int r = it - O_GU, le = r / I_GU1, q = r % I_GU1, l = le / 65, e = le % 65, nb = q % 32, kb = 2 * (q / 32) + hf;
            const float* src = e < 64 ? F.in[10] + ((size_t)(l * 64 + e)) * D * 1024 : F.in[12] + (size_t)l * D * 1024;
            d.W = src + (size_t)(64 * kb) * 1024 + map_gu(32 * nb); d.ldw = 1024; d.f8 = (FP8_MASK >> l) & 1; d.Kb = d.f8 ? D : D * 2;
            d.WT = ws + WS_WGU + (size_t)l * WGU_L + ((size_t)e * 1024 + 32 * nb) * d.Kb + (d.f8 ? 64 : 128) * kb; }
        else { const int r = it - O_D, le = r / I_D1, q = r % I_D1, l = le / 65, e = le % 65, nb = q % 64, kb = 2 * (q / 64) + hf;
            const float* src = e < 64 ? F.in[11] + ((size_t)(l * 64 + e)) * EH * D : F.in[13] + (size_t)l * EH * D;
            d.W = src + (size_t)(64 * kb) * D + 32 * nb; d.ldw = D; d.f8 = (FP8_MASK >> l) & 1; d.Kb = d.f8 ? EH : EH * 2;
            d.WT = ws + WS_WD + (size_t)l * WD_L + ((size_t)e * D + 32 * nb) * d.Kb + (d.f8 ? 64 : 128) * kb; }
        return d; };
    gu32* cq = F.ctl + CW_CVTQ;
    auto pull = [&]() -> int { unsigned v = 0u; if (lane == 0) v = __hip_atomic_fetch_add(cq, 1u, RLX_AGENT); return __builtin_amdgcn_readfirstlane((int)v); };
    int chunk_end = 0, nextchunk = 0; bool no_more = false;
    int it;
    if constexpr (DYN) { const int c0 = pull(); no_more = c0 >= limit; nextchunk = no_more ? CVT_NCHUNK : pull(); no_more = no_more || nextchunk >= limit;
        if (c0 >= CVT_NCHUNK) it = END; else { it = 2 * (O_GU + c0 * CVT_CH); chunk_end = O_GU + (c0 + 1) * CVT_CH; } }
    else it = gw < O_GU ? 2 * gw : END;
    auto advance = [&](int cur) -> int {
        if (!(cur & 1)) return cur + 1;
        if constexpr (DYN) { const int s = (cur >> 1) + 1; if (s < chunk_end) return 2 * s;
            const int c = nextchunk; if (c >= CVT_NCHUNK) return END; nextchunk = no_more ? CVT_NCHUNK : pull(); no_more = no_more || nextchunk >= limit; chunk_end = O_GU + (c + 1) * CVT_CH; return 2 * (O_GU + c * CVT_CH); }
        else { const int s = (cur >> 1) + NGW; return s < O_GU ? 2 * s : END; } };
    const int r8 = lane >> 3, c4 = (lane & 7) * 4;
    f32x4 va[8], vb[8];
    TrD dc{};
    if (it != END) { dc = decode(it);
#pragma unroll
        for (int i = 0; i < 8; ++i) va[i] = *(const GAS f32x4*)(dc.W + (size_t)(8 * i + r8) * dc.ldw + c4); }
    while (it != END) {
        const int itn = advance(it); TrD dn = dc;
        if (itn != END) { dn = decode(itn);
#pragma unroll
            for (int i = 0; i < 8; ++i) vb[i] = *(const GAS f32x4*)(dn.W + (size_t)(8 * i + r8) * dn.ldw + c4); }
#pragma unroll
        for (int i = 0; i < 8; ++i) { LAS float* p = scr + (8 * i + r8) * 33 + c4; p[0] = va[i].x; p[1] = va[i].y; p[2] = va[i].z; p[3] = va[i].w; }
        LDS_WAIT(); asm volatile("" ::: "memory");
        if (dc.f8) { const int c = lane & 3;
#pragma unroll
            for (int h = 0; h < 2; ++h) { const int n = (lane >> 2) + 16 * h; const LAS float* s = scr + (16 * c) * 33 + n;
                v4u o;
                o.x = pg8::pk4_fp8(s[0 * 33] * W8SCALE, s[1 * 33] * W8SCALE, s[2 * 33] * W8SCALE, s[3 * 33] * W8SCALE);
                o.y = pg8::pk4_fp8(s[4 * 33] * W8SCALE, s[5 * 33] * W8SCALE, s[6 * 33] * W8SCALE, s[7 * 33] * W8SCALE);
                o.z = pg8::pk4_fp8(s[8 * 33] * W8SCALE, s[9 * 33] * W8SCALE, s[10 * 33] * W8SCALE, s[11 * 33] * W8SCALE);
                o.w = pg8::pk4_fp8(s[12 * 33] * W8SCALE, s[13 * 33] * W8SCALE, s[14 * 33] * W8SCALE, s[15 * 33] * W8SCALE);
                *(GAS v4u*)(dc.WT + (size_t)n * dc.Kb + 16 * c) = o; } }
        else { const int c = lane & 7;
#pragma unroll
            for (int j = 0; j < 4; ++j) { const int n = (lane >> 3) + 8 * j; const LAS float* s = scr + (8 * c) * 33 + n;
                v4u o; o.x = pk2(s[0 * 33], s[1 * 33]); o.y = pk2(s[2 * 33], s[3 * 33]); o.z = pk2(s[4 * 33], s[5 * 33]); o.w = pk2(s[6 * 33], s[7 * 33]);
                *(GAS v4u*)(dc.WT + (size_t)n * dc.Kb + 16 * c) = o; } }
        LDS_WAIT(); asm volatile("" ::: "memory");
#pragma unroll
        for (int i = 0; i < 8; ++i) va[i] = vb[i];
        dc = dn; it = itn;
    }
}

__device__ __forceinline__ void p0_prologue(Frame& F) {
    LAS float* scr = (LAS float*)(F.lds + RING_OFF + F.wave * 16384);
    const int gw = F.vcu * NWAVES + F.wave, NGW = F.G * NWAVES, lane = F.lane;
    unsigned char* ws = F.ws;
    {
        const float* x = F.in[0]; const float* win = F.in[1]; const float* bfv = F.in[2];
        bf16* xb = (bf16*)(ws + WS_XB); float* logf = (float*)(ws + WS_LOGF);
        const int r = lane & 15, kq = lane >> 4;
        for (int grp = gw; grp < T / 16; grp += NGW) {
            const float* xr = x + (size_t)(grp * 16 + r) * D + 4 * kq; bf16* xo = xb + (size_t)(grp * 16 + r) * D + 4 * kq;
            const float* wf = win + NQKV_A + r + (size_t)(4 * kq) * LDWIN;
            f32x4 acc = {0.f, 0.f, 0.f, 0.f};
#pragma unroll 4
            for (int j = 0; j < D / 16; ++j) {
                const f32x4 xv = *(const f32x4*)(xr + 16 * j);
                const float* wp = wf + (size_t)(16 * j) * LDWIN;
                const float w0 = wp[0], w1 = wp[LDWIN], w2 = wp[2 * LDWIN], w3 = wp[3 * LDWIN];
                acc = __builtin_amdgcn_mfma_f32_16x16x4f32(xv[0], w0, acc, 0, 0, 0);
                acc = __builtin_amdgcn_mfma_f32_16x16x4f32(xv[1], w1, acc, 0, 0, 0);
                acc = __builtin_amdgcn_mfma_f32_16x16x4f32(xv[2], w2, acc, 0, 0, 0);
                acc = __builtin_amdgcn_mfma_f32_16x16x4f32(xv[3], w3, acc, 0, 0, 0);
                v2u o; o.x = pk2(xv[0], xv[1]); o.y = pk2(xv[2], xv[3]); *(GAS v2u*)(xo + 16 * j) = o;
            }
            const float bb = bfv[r];
#pragma unroll
            for (int i = 0; i < 4; ++i) { const float z = acc[i] + bb; const float ls = -(fmaxf(-z, 0.f) + log1pf(expf(-fabsf(z))));
                logf[(size_t)(grp * 16 + 4 * kq + i) * 16 + r] = ls; }
        }
    }
    {
        { float* nz = (float*)(ws + WS_NRM); for (int i = gw * 64 + lane; i < 2 * 64 * SEQ; i += NGW * 64) nz[i] = 0.f; }
        float* cs = (float*)(ws + WS_ROPE); float* sn = cs + SEQ * 32;
        const int gt = gw * 64 + lane, NGT = NGW * 64;
        for (int i = gt; i < SEQ * 32; i += NGT) { const int pos = i >> 5, d = i & 31;
            const double inv = exp(-(double)d * (9.210340371976184 / 32.0)); const double ang = (double)pos * inv;
            cs[i] = (float)cos(ang); sn[i] = (float)sin(ang); }
        float* GT = (float*)(ws + WS_GT); float* c1 = GT + 2 * 64 * 2048; float* c0 = c1 + 128;
        for (int it = gw; it < 128; it += NGW) { const int l = it >> 6, e = it & 63;
            const float* rw = F.in[8] + (size_t)l * D * 64 + e; const float* g = F.in[14] + l * D; const float* b = F.in[15] + l * D;
            float s1 = 0.f, s0 = 0.f;
            for (int k = lane; k < D; k += 64) { const float w = rw[(size_t)k * 64]; const float gv = g[k] * w; GT[(size_t)it * D + k] = gv; s1 += gv; s0 += b[k] * w; }
            s1 = wave_sum(s1); s0 = wave_sum(s0);
            if (lane == 0) { c1[it] = s1; c0[it] = s0; } }
    }
    convert_weights<false>(F, scr);
}

__device__ __forceinline__ void p1_scan(Frame& F) {
    LAS double* sh = (LAS double*)(F.lds + RING_OFF);
    const float* logf = (const float*)(F.ws + WS_LOGF); float* cb = (float*)(F.ws + WS_CB);
    for (int ch = blockIdx.x; ch < 64; ch += F.G) {
        const int b = ch >> 4, h = ch & 15; const int s0 = F.tid * 8;
        double v[8]; double run = 0.0;
#pragma unroll
        for (int i = 0; i < 8; ++i) { run += (double)logf[((size_t)b * SEQ + s0 + i) * 16 + h]; v[i] = run; }
        double inc = run;
#pragma unroll
        for (int o = 1; o < 64; o <<= 1) { const double n = __shfl_up(inc, o); if (F.lane >= o) inc += n; }
        if (F.lane == 63) sh[F.wave] = inc;
        __syncthreads();
        double base = 0.0;
        for (int w = 0; w < F.wave; ++w) base += sh[w];
        base += inc - run;
#pragma unroll
        for (int i = 0; i < 8; ++i) cb[(size_t)ch * SEQ + s0 + i] = (float)(-(base + v[i]) * 1.4426950408889634);
        __syncthreads();
    }
}

template <bool XF32>
__device__ __forceinline__ void ln_router_phase(Frame& F, int l, const void* xres, const bf16* hmix, bf16* x1b, unsigned char* x1q) {
    const int lane = F.lane;
    auto ldy = [&](size_t elem) -> f32x4 {
        const v2u hw_ = *(const GAS v2u*)(hmix + elem); f32x4 xv;
        if constexpr (XF32) xv = *(const GAS f32x4*)((const float*)xres + elem);
        else { const v2u xw = *(const GAS v2u*)((const bf16*)xres + elem); xv = (f32x4){bf_lo(xw.x), bf_hi(xw.x), bf_lo(xw.y), bf_hi(xw.y)}; }
        return xv * ALPHA + (f32x4){bf_lo(hw_.x), bf_hi(hw_.x), bf_lo(hw_.y), bf_hi(hw_.y)}; };
    LAS float* wsc = (LAS float*)(F.lds + RING_OFF + F.wave * 8704);
    LAS float* sc = wsc; LAS float* chs = wsc + 16 * 65; LAS unsigned* hw = (LAS unsigned*)(wsc + 2 * 16 * 65);
    LAS float* smean = (LAS float*)(F.lds + RING_OFF + 8 * 8704); LAS float* srstd = smean + 64;
    const float* g = F.in[14] + l * D; const float* bta = F.in[15] + l * D;
    const float* GT = (const float*)(F.ws + WS_GT) + (size_t)l * 64 * D; const float* c1 = (const float*)(F.ws + WS_GT) + 2 * 64 * D + l * 64; const float* c0 = c1 + 128;
    const float* rbias = F.in[9] + l * 64;
    int* eidx = (int*)(F.ws + WS_EIDX); float* wts = (float*)(F.ws + WS_WTS); unsigned* ghist = (unsigned*)(F.ws + WS_GHIST);
    for (int chunk = F.vcu; chunk < T / 64; chunk += F.G) {
        for (int rr = 0; rr < 8; rr += 2) {
            const int lr = F.wave * 8 + rr; const size_t row = (size_t)chunk * 64 + lr;
            f32x4 v[2][8]; float s[2] = {0.f, 0.f};
#pragma unroll
            for (int q = 0; q < 2; ++q)
#pragma unroll
                for (int j = 0; j < 8; ++j) v[q][j] = ldy((row + q) * D + 4 * lane + 256 * j);
#pragma unroll
            for (int q = 0; q < 2; ++q)
#pragma unroll
                for (int j = 0; j < 8; ++j) s[q] += (v[q][j].x + v[q][j].y) + (v[q][j].z + v[q][j].w);
            float mean[2], rstd[2], s2[2] = {0.f, 0.f};
#pragma unroll
            for (int o = 1; o < 64; o <<= 1) { s[0] += __shfl_xor(s[0], o); s[1] += __shfl_xor(s[1], o); }
#pragma unroll
            for (int q = 0; q < 2; ++q) { mean[q] = s[q] * (1.f / D);
#pragma unroll
                for (int j = 0; j < 8; ++j) { v[q][j] = v[q][j] - mean[q]; s2[q] += (v[q][j].x * v[q][j].x + v[q][j].y * v[q][j].y) + (v[q][j].z * v[q][j].z + v[q][j].w * v[q][j].w); } }
#pragma unroll
            for (int o = 1; o < 64; o <<= 1) { s2[0] += __shfl_xor(s2[0], o); s2[1] += __shfl_xor(s2[1], o); }
#pragma unroll
            for (int q = 0; q < 2; ++q) { rstd[q] = 1.f / sqrtf(s2[q] * (1.f / D) + LN_EPS); if (lane == 0) { smean[lr + q] = mean[q]; srstd[lr + q] = rstd[q]; } }
#pragma unroll
            for (int j = 0; j < 8; ++j) { const f32x4 gv = *((const GAS f32x4*)g + lane + 64 * j), bv = *((const GAS f32x4*)bta + lane + 64 * j);
#pragma unroll
                for (int q = 0; q < 2; ++q) { const f32x4 o = v[q][j] * rstd[q] * gv + bv; v2u w; w.x = pk2(o.x, o.y); w.y = pk2(o.z, o.w);
                    ((GAS v2u*)(x1b + (row + q) * D) + lane)[64 * j] = w;
                    if (x1q) ((GAS unsigned*)(x1q + (row + q) * D) + lane)[64 * j] = pg8::pk4_fp8(o.x, o.y, o.z, o.w); } }
        }
        LDS_WAIT();
        __syncthreads();
        {
            const int grp = chunk * 4 + (F.wave & 3), kh = F.wave >> 2;
            const int r = lane & 15, kq = lane >> 4;
            const size_t yo = ((size_t)grp * 16 + r) * D + 4 * kq + kh * (D / 2); const float* gt = GT + (size_t)r * D + 4 * kq + kh * (D / 2);
            f32x4 acc[4];
#pragma unroll
            for (int nt = 0; nt < 4; ++nt) acc[nt] = (f32x4){0.f, 0.f, 0.f, 0.f};
#pragma unroll 4
            for (int j = 0; j < D / 32; ++j) {
                const f32x4 yv = ldy(yo + 16 * j);
#pragma unroll
                for (int nt = 0; nt < 4; ++nt) { const f32x4 wv = *(const f32x4*)(gt + (size_t)(16 * nt) * D + 16 * j);
                    acc[nt] = __builtin_amdgcn_mfma_f32_16x16x4f32(yv[0], wv[0], acc[nt], 0, 0, 0);
                    acc[nt] = __builtin_amdgcn_mfma_f32_16x16x4f32(yv[1], wv[1], acc[nt], 0, 0, 0);
                    acc[nt] = __builtin_amdgcn_mfma_f32_16x16x4f32(yv[2], wv[2], acc[nt], 0, 0, 0);
                    acc[nt] = __builtin_amdgcn_mfma_f32_16x16x4f32(yv[3], wv[3], acc[nt], 0, 0, 0); }
            }
            LAS f32x4* px = (LAS f32x4*)(F.lds + RING_OFF + 8 * 8704 + 1024) + (F.wave & 3) * 256;
            if (kh) {
#pragma unroll
                for (int nt = 0; nt < 4; ++nt) px[nt * 64 + lane] = acc[nt]; }
            LDS_WAIT();
            __syncthreads();
            if (!kh) {
#pragma unroll
            for (int nt = 0; nt < 4; ++nt) acc[nt] = acc[nt] + px[nt * 64 + lane];
            hw[lane] = 0u;
#pragma unroll
            for (int nt = 0; nt < 4; ++nt) { const int e = 16 * nt + r; const float cc1 = c1[e], cc0 = c0[e], rb = rbias[e];
#pragma unroll
                for (int i = 0; i < 4; ++i) { const int rw_ = 4 * kq + i; const float lg = srstd[F.wave * 16 + rw_] * (acc[nt][i] - smean[F.wave * 16 + rw_] * cc1) + cc0;
                    const float s = 1.f / (1.f + expf(-lg)); sc[rw_ * 65 + e] = s; chs[rw_ * 65 + e] = s + rb; } }
            LDS_WAIT(); asm volatile("" ::: "memory");
            if (lane < 16) {
                const LAS float* ch = chs + lane * 65; const LAS float* so = sc + lane * 65;
                float gs[8];
#pragma unroll
                for (int gi = 0; gi < 8; ++gi) { float m1 = -__builtin_inff(), m2 = -__builtin_inff();
#pragma unroll
                    for (int i = 0; i < 8; ++i) { const float v = ch[gi * 8 + i]; if (v > m1) { m2 = m1; m1 = v; } else if (v > m2) m2 = v; }
                    gs[gi] = m1 + m2; }
                unsigned gmask = 0u;
#pragma unroll
                for (int gi = 0; gi < 8; ++gi) { int cnt = 0;
#pragma unroll
                    for (int gj = 0; gj < 8; ++gj) cnt += (gs[gj] > gs[gi] || (gs[gj] == gs[gi] && gj < gi)) ? 1 : 0;
                    if (cnt < 4) gmask |= 1u << gi; }
                unsigned long long chosen = 0ull; int ei[8]; float ew[8]; float wsum = 0.f;
#pragma unroll
                for (int k = 0; k < 8; ++k) { float best = -__builtin_inff(); int bi = 0;
                    for (int e = 0; e < 64; ++e) { const bool ok = ((gmask >> (e >> 3)) & 1u) && !((chosen >> e) & 1ull); const float v = ch[e]; if (ok && v > best) { best = v; bi = e; } }
                    chosen |= 1ull << bi; ei[k] = bi; ew[k] = so[bi]; wsum += ew[k]; }
                const size_t row = (size_t)grp * 16 + lane; const float sc_ = 2.5f / wsum;
#pragma unroll
                for (int k = 0; k < 8; ++k) { eidx[row * 8 + k] = ei[k]; wts[row * 8 + k] = ew[k] * sc_; atomicAdd((unsigned*)&hw[ei[k]], 1u); }
            }
            LDS_WAIT(); asm volatile("" ::: "memory");
            ghist[(size_t)grp * 64 + lane] = hw[lane];
            }
        }
        __syncthreads();
    }
}

__device__ __forceinline__ void dispatch_phase(Frame& F, int l) {
    LAS int* cnt = (LAS int*)(F.lds + RING_OFF); LAS int* rstart = cnt + 64; LAS int* tstart = rstart + 64; LAS int* lntr = tstart + 64;
    LAS int* part_tot = lntr + 64; LAS int* part_bef = part_tot + 512; LAS int* gbase = part_bef + 512; LAS int* lh = gbase + 256;
    const int* eidx = (const int*)(F.ws + WS_EIDX); const float* wts = (const float*)(F.ws + WS_WTS); const unsigned* ghist = (const unsigned*)(F.ws + WS_GHIST);
    int* slot = (int*)(F.ws + WS_SLOT); int* tok = (int*)(F.ws + WS_TOK); float* gate = (float*)(F.ws + WS_GATE); int* tile_e = (int*)(F.ws + WS_TILE);
    const int NG = T / 16;
    for (int chunk = blockIdx.x; chunk < T / 64; chunk += F.G) {
        { const int e = F.tid & 63, part = F.tid >> 6; int tot = 0, bef = 0; const int g0 = part * (NG / 8), gfirst = chunk * 4;
          for (int gq = g0; gq < g0 + NG / 8; ++gq) { const int v = (int)ghist[(size_t)gq * 64 + e]; tot += v; bef += (gq < gfirst) ? v : 0; }
          part_tot[part * 64 + e] = tot; part_bef[part * 64 + e] = bef; }
        if (F.tid < 256) lh[F.tid] = 0;
        __syncthreads();
        if (F.tid < 64) { int tot = 0, bef = 0;
#pragma unroll
            for (int p = 0; p < 8; ++p) { tot += part_tot[p * 64 + F.tid]; bef += part_bef[p * 64 + F.tid]; }
            cnt[F.tid] = tot; int run = bef;
#pragma unroll
            for (int gl = 0; gl < 4; ++gl) { gbase[gl * 64 + F.tid] = run; run += (int)ghist[(size_t)(chunk * 4 + gl) * 64 + F.tid]; } }
        __syncthreads();
        if (F.tid == 0) { int ts = 0; for (int e = 0; e < 64; ++e) { tstart[e] = ts; rstart[e] = ts * 256; ts += (cnt[e] + 255) >> 8; } lntr[0] = ts; }
        __syncthreads();
        const int a = chunk * 512 + F.tid; const int e = eidx[a]; const int gl = F.tid >> 7;
        const int lr = atomicAdd((int*)&lh[gl * 64 + e], 1);
        const int dest = rstart[e] + gbase[gl * 64 + e] + lr;
        tok[dest] = a >> 3; gate[dest] = wts[a]; slot[a] = dest;
        __syncthreads();
    }
    if (blockIdx.x >= T / 64) {
        { const int e = F.tid & 63, part = F.tid >> 6; int tot = 0; const int g0 = part * (NG / 8);
          for (int gq = g0; gq < g0 + NG / 8; ++gq) tot += (int)ghist[(size_t)gq * 64 + e];
          part_tot[part * 64 + e] = tot; }
        __syncthreads();
        if (F.tid < 64) { int tot = 0;
#pragma unroll
            for (int p = 0; p < 8; ++p) tot += part_tot[p * 64 + F.tid];
            cnt[F.tid] = tot; }
        __syncthreads();
        if (F.tid == 0) { int ts = 0; for (int e = 0; e < 64; ++e) { tstart[e] = ts; rstart[e] = ts * 256; ts += (cnt[e] + 255) >> 8; } lntr[0] = ts; }
        __syncthreads();
    }
    const int ntr = lntr[0], rpad = ntr * 256;
    if (blockIdx.x == 0 && F.tid == 0) { __hip_atomic_store(F.ctl + CW_NT + l, (unsigned)(ntr + 64), RLX_AGENT); __hip_atomic_store(F.ctl + CW_NT + 2 + l, (unsigned)rpad, RLX_AGENT); }
    for (int e = blockIdx.x; e < 64; e += F.G) {
        const int nt_e = (cnt[e] + 255) >> 8;
        for (int i = cnt[e] + F.tid; i < nt_e * 256; i += NWAVES * 64) { tok[rstart[e] + i] = 0; gate[rstart[e] + i] = 0.f; }
        for (int i = F.tid; i < nt_e; i += NWAVES * 64) tile_e[tstart[e] + i] = e;
    }
    for (int i = blockIdx.x * (NWAVES * 64) + F.tid; i < T; i += F.G * NWAVES * 64) { tok[rpad + i] = i; gate[rpad + i] = 1.f; }
    if (blockIdx.x == 0 && F.tid < 64) tile_e[ntr + F.tid] = 64;
}

typedef float f32x2_ __attribute__((ext_vector_type(2)));
template <bool Y8, bool OF32, bool OB16>
__device__ __forceinline__ void combine_ln_phase(Frame& F, int l, const bf16* x1b, float* out, bf16* outb) {
    const int gw = F.vcu * NWAVES + F.wave, NGW = F.G * NWAVES, lane = F.lane;
    const int* slot = (const int*)(F.ws + WS_SLOT); const unsigned char* yp = F.ws + WS_YP; const float* wts = (const float*)(F.ws + WS_WTS);
    const int rpad = (int)__hip_atomic_load(F.ctl + CW_NT + 2 + l, RLX_AGENT);
    const float* g = F.in[16] + l * D; const float* bta = F.in[17] + l * D;
    constexpr float YS = Y8 ? (1.f / 16.f) : 1.f; constexpr int YB = Y8 ? 1 : 2;
    for (int row = gw; row < T; row += NGW) {
        float v[4][8];
#pragma unroll
        for (int j = 0; j < 4; ++j) { const v4u w = *((const GAS v4u*)(x1b + (size_t)row * D) + lane + 64 * j);
            v[j][0] = bf_lo(w.x) * ALPHA; v[j][1] = bf_hi(w.x) * ALPHA; v[j][2] = bf_lo(w.y) * ALPHA; v[j][3] = bf_hi(w.y) * ALPHA;
            v[j][4] = bf_lo(w.z) * ALPHA; v[j][5] = bf_hi(w.z) * ALPHA; v[j][6] = bf_lo(w.w) * ALPHA; v[j][7] = bf_hi(w.w) * ALPHA; }
        int src[9]; float gw_[9];
#pragma unroll
        for (int k = 0; k < 8; ++k) { src[k] = __builtin_amdgcn_readfirstlane(slot[(size_t)row * 8 + k]); gw_[k] = YS * __builtin_bit_cast(float, __builtin_amdgcn_readfirstlane(__builtin_bit_cast(int, wts[(size_t)row * 8 + k]))); }
        src[8] = rpad + row; gw_[8] = YS;
#pragma unroll
        for (int k = 0; k < 9; ++k) { const unsigned char* yr = yp + (size_t)src[k] * (D * YB); const float gk = gw_[k];
#pragma unroll
            for (int j = 0; j < 4; ++j) {
                if constexpr (Y8) { const v2u w = *((const GAS v2u*)yr + lane + 64 * j);
                    const f32x2_ a = __builtin_amdgcn_cvt_pk_f32_fp8((int)w.x, false), b = __builtin_amdgcn_cvt_pk_f32_fp8((int)w.x, true), c = __builtin_amdgcn_cvt_pk_f32_fp8((int)w.y, false), d = __builtin_amdgcn_cvt_pk_f32_fp8((int)w.y, true);
                    v[j][0] += gk * a.x; v[j][1] += gk * a.y; v[j][2] += gk * b.x; v[j][3] += gk * b.y; v[j][4] += gk * c.x; v[j][5] += gk * c.y; v[j][6] += gk * d.x; v[j][7] += gk * d.y; }
                else { const v4u w = *((const GAS v4u*)yr + lane + 64 * j);
                    v[j][0] += gk * bf_lo(w.x); v[j][1] += gk * bf_hi(w.x); v[j][2] += gk * bf_lo(w.y); v[j][3] += gk * bf_hi(w.y); v[j][4] += gk * bf_lo(w.z); v[j][5] += gk * bf_hi(w.z); v[j][6] += gk * bf_lo(w.w); v[j][7] += gk * bf_hi(w.w); } } }
        float s = 0.f;
#pragma unroll
        for (int j = 0; j < 4; ++j)
#pragma unroll
            for (int i = 0; i < 8; ++i) s += v[j][i];
        const float mean = wave_sum(s) * (1.f / D); float s2 = 0.f;
#pragma unroll
        for (int j = 0; j < 4; ++j)
#pragma unroll
            for (int i = 0; i < 8; ++i) { v[j][i] -= mean; s2 += v[j][i] * v[j][i]; }
        const float rstd = 1.f / sqrtf(wave_sum(s2) * (1.f / D) + LN_EPS);
#pragma unroll
        for (int j = 0; j < 4; ++j) { const int c0 = 8 * lane + 512 * j;
            const f32x4 g0 = *(const GAS f32x4*)(g + c0), g1 = *(const GAS f32x4*)(g + c0 + 4), b0 = *(const GAS f32x4*)(bta + c0), b1 = *(const GAS f32x4*)(bta + c0 + 4);
            const f32x4 o0 = (f32x4){v[j][0], v[j][1], v[j][2], v[j][3]} * rstd * g0 + b0, o1 = (f32x4){v[j][4], v[j][5], v[j][6], v[j][7]} * rstd * g1 + b1;
            if constexpr (OF32) { GAS f32x4* xo = (GAS f32x4*)(out + (size_t)row * D + c0); xo[0] = o0; xo[1] = o1; }
            if constexpr (OB16) { v4u w; w.x = pk2(o0.x, o0.y); w.y = pk2(o0.z, o0.w); w.z = pk2(o1.x, o1.y); w.w = pk2(o1.z, o1.w); *(GAS v4u*)(outb + (size_t)row * D + c0) = w; } }
    }
}
#ifndef P1_CVT_LIMIT
#define P1_CVT_LIMIT 2400
#endif
#ifndef CVT_ATT_GROUPS
#define CVT_ATT_GROUPS 20
#endif
#ifndef DOWN_ALIGN
#define DOWN_ALIGN true
#endif
struct Args { const float* in[18]; float* out; unsigned char* ws; int ph_lo, ph_hi; };
__global__ void __launch_bounds__(NWAVES * 64, 2) yoco_fwd(Args args) {
    extern __shared__ __attribute__((aligned(16))) unsigned char lds[];
    Frame F;
    F.lds = (LAS unsigned char*)lds;
    F.tid = threadIdx.x; F.lane = F.tid & 63; F.wave = __builtin_amdgcn_readfirstlane(F.tid >> 6);
    F.G = gridDim.x; { const int bx = blockIdx.x; F.vcu = (F.G % 8 == 0) ? (bx % 8) * (F.G / 8) + bx / 8 : bx; }
    unsigned char* ws = args.ws; F.ws = ws;
    F.ctl = (gu32*)(ws + WS_CTL);
#pragma unroll
    for (int i = 0; i < 18; ++i) F.in[i] = args.in[i];
    F.out = args.out;
    for (int u = F.tid; u < (LDS_BYTES - LDSCTL_OFF) / 4; u += NWAVES * 64) ((LAS unsigned*)(F.lds + LDSCTL_OFF))[u] = 0u;
    __syncthreads();
    XcdBarrier bar; bar.bar = (unsigned*)(F.ctl + CW_BAR); bar.x = 0; bar.st = nullptr;
    if (!MK_PER_PHASE) bar = xcd_barrier_post((unsigned*)(F.ctl + CW_BAR), (volatile LAS unsigned*)(F.lds + MISC_OFF) + 8);
    const int lo = args.ph_lo, hi = args.ph_hi;
#define IN(k) (lo <= (k) && (k) < hi)
#define SEAM(k) do { if (IN(k) && IN((k) + 1)) xcd_barrier(bar); } while (0)
#ifndef DUP_MASK
#define DUP_MASK 0
#endif
#define DUP(k) ((DUP_MASK >> (k)) & 1)
#define REP(k) _Pragma("unroll") for (int rep_ = 0; rep_ <= DUP(k); ++rep_)
    bf16* XB = (bf16*)(ws + WS_XB); bf16* QB = (bf16*)(ws + WS_QB); bf16* KB = (bf16*)(ws + WS_KB); bf16* VB = (bf16*)(ws + WS_VB); bf16* AO = (bf16*)(ws + WS_AO);
    bf16* HM = (bf16*)(ws + WS_Y1);
    unsigned char* X1Q = ws + WS_X1; bf16* X1B = (bf16*)(ws + WS_X1B); bf16* ACT = (bf16*)(ws + WS_ACT); bf16* YP = (bf16*)(ws + WS_YP); float* X2 = (float*)(ws + WS_X2);
    const int* tokp = (const int*)(ws + WS_TOK); const float* gatep = (const float*)(ws + WS_GATE); const int* tile_e = (const int*)(ws + WS_TILE);

    if (IN(0)) REP(0) { if (rep_) xcd_barrier(bar); asm volatile("" : "+v"(F.tid)); F.lane = F.tid & 63; p0_prologue(F); } SEAM(0);
    if (IN(1)) REP(1) { if (rep_) xcd_barrier(bar); asm volatile("" : "+v"(F.tid)); F.lane = F.tid & 63;
        p1_scan(F);
        if (F.G == 256 && P1_CVT_LIMIT > 0 && (int)(blockIdx.x >> 3) >= 24) { if (rep_ == 0) convert_weights<true>(F, (LAS float*)(F.lds + RING_OFF + F.wave * 16384), P1_CVT_LIMIT); }
        else {
        pg8::Gemm g{XB, (const bf16*)(ws + WS_WQKV_A), D, nullptr}; pg8::StaticOrder S; S.init(T, NQKV_A, (F.G == 256 && P1_CVT_LIMIT > 0) ? 192 : F.G, (int)blockIdx.x);
        pg8::EpiQKVn E{QB, (size_t)(WS_KB - WS_QB) / 2, QSCALE_A, (float*)(ws + WS_NRM), (float*)(ws + WS_NRM) + 64 * SEQ};
        pg8::gemm_phase<pg8::EpiQKVn, pg8::StaticOrder, true, false>(F.lds + RING_OFF, g, S, E);
        }
    } SEAM(1);
    if (IN(2)) REP(2) { if (rep_) xcd_barrier(bar); asm volatile("" : "+v"(F.tid)); F.lane = F.tid & 63;
        for (int L = blockIdx.x; L < 1024; L += F.G) fox::fox_jlo_item((char*)lds + RING_OFF, L, (const float*)(ws + WS_CB), (const float*)(ws + WS_NRM), (const float*)(ws + WS_NRM) + 64 * SEQ, (int*)(ws + WS_NRM + 2 * 64 * SEQ * 4)); } SEAM(2);
    if (IN(3)) for (int rep_ = 0, nrep_ = (DUP(3) && hi >= N_PHASES) ? 2 : 1; rep_ < nrep_; ++rep_) { if (rep_) xcd_barrier(bar); asm volatile("" : "+v"(F.tid)); F.lane = F.tid & 63;
        const bool att_first = (int)(blockIdx.x >> 3) < CVT_ATT_GROUPS;
        if (!att_first && rep_ == 0) convert_weights<true>(F, (LAS float*)(F.lds + RING_OFF + F.wave * 16384));
        fox::fox_phase((char*)lds + RING_OFF, (const fox::bf16*)QB, (const fox::bf16*)KB, (const fox::bf16*)VB, (fox::bf16*)AO, (const float*)(ws + WS_CB), (unsigned*)(F.ctl + CW_FOXQ), (const int*)(ws + WS_NRM + 2 * 64 * SEQ * 4));
        __syncthreads();
        if (att_first && rep_ == 0) convert_weights<true>(F, (LAS float*)(F.lds + RING_OFF + F.wave * 16384)); } SEAM(3);
    if (IN(4)) REP(4) { if (rep_) xcd_barrier(bar); asm volatile("" : "+v"(F.tid)); F.lane = F.tid & 63;
        pg8::Gemm g{AO, (const bf16*)(ws + WS_WO_A), D, nullptr}; pg8::StaticOrder S; S.init(T, D, F.G, (int)blockIdx.x);
        pg8::EpiBf16 E{HM, D, 0, 0, 1.f};
        pg8::gemm_phase<pg8::EpiBf16, pg8::StaticOrder, true, false>(F.lds + RING_OFF, g, S, E);
    } SEAM(4);
    if (IN(5)) REP(5) { if (rep_) xcd_barrier(bar); asm volatile("" : "+v"(F.tid)); F.lane = F.tid & 63; ln_router_phase<true>(F, 0, F.in[0], HM, X1B, (FP8_MASK & 1) ? X1Q : nullptr); } SEAM(5);
    if (IN(6)) REP(6) { if (rep_) xcd_barrier(bar); asm volatile("" : "+v"(F.tid)); F.lane = F.tid & 63; dispatch_phase(F, 0); } SEAM(6);
    if (IN(7)) REP(7) { if (rep_) xcd_barrier(bar); asm volatile("" : "+v"(F.tid)); F.lane = F.tid & 63;
        const int ntl = (int)__hip_atomic_load(F.ctl + CW_NT + 0, RLX_AGENT);
        pg8::GroupedOrder S; S.init(ntl, 4, F.G, (int)blockIdx.x, tile_e);
        if constexpr ((FP8_MASK >> 0) & 1) { pg8::Gemm g{(const bf16*)X1Q, (const bf16*)(ws + WS_WGU), D / 2, tokp}; pg8::EpiSwiglu8 E{(unsigned char*)ACT, EH, 1.f};
            pg8::gemm_phase<pg8::EpiSwiglu8, pg8::GroupedOrder, true, true, true>(F.lds + RING_OFF, g, S, E); }
        else { pg8::Gemm g{X1B, (const bf16*)(ws + WS_WGU), D, tokp}; pg8::EpiSwiglu E{ACT, EH};
            pg8::gemm_phase<pg8::EpiSwiglu, pg8::GroupedOrder, true, true>(F.lds + RING_OFF, g, S, E); }
    } SEAM(7);
    if (IN(8)) REP(8) { if (rep_) xcd_barrier(bar); asm volatile("" : "+v"(F.tid)); F.lane = F.tid & 63;
        const int ntl = (int)__hip_atomic_load(F.ctl + CW_NT + 0, RLX_AGENT);
        pg8::GroupedOrder S; S.init(ntl, 8, F.G, (int)blockIdx.x, tile_e);
        if constexpr ((FP8_MASK >> 0) & 1) { pg8::Gemm g{ACT, (const bf16*)(ws + WS_WD), EH / 2, nullptr}; pg8::EpiFp8Y E{(unsigned char*)YP, D};
            pg8::gemm_phase<pg8::EpiFp8Y, pg8::GroupedOrder, DOWN_ALIGN, false, true>(F.lds + RING_OFF, g, S, E); }
        else { pg8::Gemm g{ACT, (const bf16*)(ws + WS_WD), EH, nullptr}; pg8::EpiBf16NT E{YP, D, 0, 0, 1.f};
            pg8::gemm_phase<pg8::EpiBf16NT, pg8::GroupedOrder, DOWN_ALIGN, false>(F.lds + RING_OFF, g, S, E); }
    } SEAM(8);
    if (IN(9)) REP(9) { if (rep_) xcd_barrier(bar); asm volatile("" : "+v"(F.tid)); F.lane = F.tid & 63; combine_ln_phase<(FP8_MASK & 1) != 0, false, true>(F, 0, X1B, nullptr, XB); } SEAM(9);
    if (IN(10)) REP(10) { if (rep_) xcd_barrier(bar); asm volatile("" : "+v"(F.tid)); F.lane = F.tid & 63;
        pg8::Gemm g{XB, (const bf16*)(ws + WS_WQKV_B), D, nullptr}; pg8::StaticOrder S; S.init(T, NQKV_B, F.G, (int)blockIdx.x);
        pg8::EpiRope E{QB, KB, KB + (size_t)T * 256, (const float*)(ws + WS_ROPE), (const float*)(ws + WS_ROPE) + SEQ * 32, QSCALE_B};
        pg8::gemm_phase<pg8::EpiRope, pg8::StaticOrder, true, false>(F.lds + RING_OFF, g, S, E);
    } SEAM(10);
    if (IN(11)) REP(11) { if (rep_) xcd_barrier(bar); asm volatile("" : "+v"(F.tid)); F.lane = F.tid & 63; swa::swa_phase((char*)lds + RING_OFF, (const swa::bf16*)QB, (const swa::bf16*)KB, (const swa::bf16*)(KB + (size_t)T * 256), (swa::bf16*)AO, F.in[6], (int)blockIdx.x, F.G); } SEAM(11);
    if (IN(12)) REP(12) { if (rep_) xcd_barrier(bar); asm volatile("" : "+v"(F.tid)); F.lane = F.tid & 63;
        pg8::Gemm g{AO, (const bf16*)(ws + WS_WO_B), D, nullptr}; pg8::StaticOrder S; S.init(T, D, F.G, (int)blockIdx.x);
        pg8::EpiBf16 E{HM, D, 0, 0, 1.f};
        pg8::gemm_phase<pg8::EpiBf16, pg8::StaticOrder, true, false>(F.lds + RING_OFF, g, S, E);
    } SEAM(12);
    if (IN(13)) REP(13) { if (rep_) xcd_barrier(bar); asm volatile("" : "+v"(F.tid)); F.lane = F.tid & 63; ln_router_phase<false>(F, 1, XB, HM, X1B, (FP8_MASK & 2) ? X1Q : nullptr); } SEAM(13);
    if (IN(14)) REP(14) { if (rep_) xcd_barrier(bar); asm volatile("" : "+v"(F.tid)); F.lane = F.tid & 63; dispatch_phase(F, 1); } SEAM(14);
    if (IN(15)) REP(15) { if (rep_) xcd_barrier(bar); asm volatile("" : "+v"(F.tid)); F.lane = F.tid & 63;
        const int ntl = (int)__hip_atomic_load(F.ctl + CW_NT + 1, RLX_AGENT);
        pg8::GroupedOrder S; S.init(ntl, 4, F.G, (int)blockIdx.x, tile_e);
        if constexpr ((FP8_MASK >> 1) & 1) { pg8::Gemm g{(const bf16*)X1Q, (const bf16*)(ws + WS_WGU + WGU_L), D / 2, tokp}; pg8::EpiSwiglu8 E{(unsigned char*)ACT, EH, 1.f};
            pg8::gemm_phase<pg8::EpiSwiglu8, pg8::GroupedOrder, true, true, true>(F.lds + RING_OFF, g, S, E); }
        else { pg8::Gemm g{X1B, (const bf16*)(ws + WS_WGU + WGU_L), D, tokp}; pg8::EpiSwiglu E{ACT, EH};
            pg8::gemm_phase<pg8::EpiSwiglu, pg8::GroupedOrder, true, true>(F.lds + RING_OFF, g, S, E); }
    } SEAM(15);
    if (IN(16)) REP(16) { if (rep_) xcd_barrier(bar); asm volatile("" : "+v"(F.tid)); F.lane = F.tid & 63;
        const int ntl = (int)__hip_atomic_load(F.ctl + CW_NT + 1, RLX_AGENT);
        pg8::GroupedOrder S; S.init(ntl, 8, F.G, (int)blockIdx.x, tile_e);
        if constexpr ((FP8_MASK >> 1) & 1) { pg8::Gemm g{ACT, (const bf16*)(ws + WS_WD + WD_L), EH / 2, nullptr}; pg8::EpiFp8Y E{(unsigned char*)YP, D};
            pg8::gemm_phase<pg8::EpiFp8Y, pg8::GroupedOrder, DOWN_ALIGN, false, true>(F.lds + RING_OFF, g, S, E); }
        else { pg8::Gemm g{ACT, (const bf16*)(ws + WS_WD + WD_L), EH, nullptr}; pg8::EpiBf16NT E{YP, D, 0, 0, 1.f};
            pg8::gemm_phase<pg8::EpiBf16NT, pg8::GroupedOrder, DOWN_ALIGN, false>(F.lds + RING_OFF, g, S, E); }
    } SEAM(16);
    if (IN(17)) REP(17) { if (rep_) xcd_barrier(bar); asm volatile("" : "+v"(F.tid)); F.lane = F.tid & 63; combine_ln_phase<(FP8_MASK & 2) != 0, true, false>(F, 1, X1B, F.out, nullptr); }
#undef IN
#undef SEAM
}

#ifndef HOST_DUP_MASK
#define HOST_DUP_MASK 0
#endif
extern "C" void kernel_launch(void* const* d_in, const int* in_sizes, int n_in, void* d_out, int out_size, void* d_ws, size_t ws_size, hipStream_t stream) {
    static int grid = 0;
    if (grid == 0) {
        if (n_in != 18 || in_sizes[0] != T * D || out_size != T * D || ws_size < WS_END) { fprintf(stderr, "kernel_launch: unexpected shapes (n_in %d, in0 %d, out %d, ws %zu); nothing launched\n", n_in, n_in > 0 ? in_sizes[0] : -1, out_size, ws_size); grid = -1; return; }
        int dev = 0, cus = 0, per_cu = 0;
        if (hipGetDevice(&dev) != hipSuccess || hipDeviceGetAttribute(&cus, hipDeviceAttributeMultiprocessorCount, dev) != hipSuccess) { grid = -1; return; }
        if (hipFuncSetAttribute((const void*)yoco_fwd, hipFuncAttributeMaxDynamicSharedMemorySize, LDS_BYTES) != hipSuccess) { fprintf(stderr, "kernel_launch: hipFuncSetAttribute failed\n"); grid = -1; return; }
        if (hipOccupancyMaxActiveBlocksPerMultiprocessor(&per_cu, (const void*)yoco_fwd, NWAVES * 64, LDS_BYTES) != hipSuccess || per_cu < 1)
            fprintf(stderr, "kernel_launch: note: occupancy query reports %d workgroups per CU\n", per_cu);
        (void)hipGetLastError();
        grid = cus;
    }
    if (grid < 0) return;
    if (hipMemsetAsync((char*)d_ws + WS_CTL, 0, CTL_ZERO_BYTES, stream) != hipSuccess) return;
    Args a{};
    for (int i = 0; i < 18; ++i) a.in[i] = (const float*)d_in[i];
    a.out = (float*)d_out; a.ws = (unsigned char*)d_ws;
#if MK_PER_PHASE
    for (int p = 0; p < N_PHASES; ++p) for (int r = 0; r <= ((HOST_DUP_MASK >> p) & 1); ++r) { a.ph_lo = p; a.ph_hi = p + 1; hipLaunchKernelGGL(yoco_fwd, dim3(grid), dim3(NWAVES * 64), LDS_BYTES, stream, a); }
#else
    a.ph_lo = 0; a.ph_hi = N_PHASES;
    hipLaunchKernelGGL(yoco_fwd, dim3(grid), dim3(NWAVES * 64), LDS_BYTES, stream, a);
#endif
    const hipError_t le = hipPeekAtLastError();
    if (le != hipSuccess) fprintf(stderr, "kernel_launch: launch failed: %s\n", hipGetErrorName(le));
}
```

```cpp
#include <hip/hip_runtime.h>
#include <hip/hip_bf16.h>
#include <cstdio>
#include <cstdint>
#include <cmath>
#define MK_PER_PHASE 0
#ifndef ATT8_MASK
#define ATT8_MASK 15
#endif
namespace pg8 {
#define PG8_LAS __attribute__((address_space(3)))
typedef unsigned short bf16_t;
typedef short bf16x8 __attribute__((ext_vector_type(8)));
typedef float f32x4 __attribute__((ext_vector_type(4)));
typedef unsigned u32x4 __attribute__((ext_vector_type(4)));
typedef int v8i __attribute__((ext_vector_type(8)));
typedef unsigned u32x2 __attribute__((ext_vector_type(2)));
constexpr int BM = 256, BK = 64, HALF = 128, HTB = HALF * BK * 2  , STAGE_BYTES = 8 * HTB, NXCD = 8, WGM = 8;

__host__ __device__ __forceinline__ int lds_byte(int r, int c) { const int st = (r >> 4) * 2 + (c >> 5), rr = r & 15, cc = c & 31, ob = rr * 64 + cc * 2; return st * 1024 + (ob ^ (((ob >> 9) & 1) << 5)); }
__host__ __device__ __forceinline__ void stage_rc(int b, int& R, int& C) { const int st = b / 1024, sb = b % 1024, swz = sb ^ (((sb >> 9) & 1) << 5); R = (st >> 1) * 16 + swz / 64; C = (st & 1) * 32 + (swz % 64) / 2; }
__host__ __device__ __forceinline__ int perm32(int rho) { const int n = rho >> 4, i = rho & 15; return 8 * (i >> 2) + 4 * n + (i & 3); }

struct Unit { int pm, pn, pb; };
struct Gemm { const bf16_t* A; const bf16_t* Bt; int K; const int* rowtab; };

struct StaticOrder {
    int nM, nN, nwg, G, c;
    __host__ __device__ void init(int M, int N, int G_, int c_) { nM = M / BM; nN = N / BM; nwg = nM * nN; G = G_; c = c_; }
    __host__ __device__ bool next(int i, Unit& u) const {
        const long L = (long)i * G + c; if (L >= nwg) return false;
        int wgid = (int)L; { const int q = nwg / NXCD, r = nwg % NXCD, xcd = wgid % NXCD, off = wgid / NXCD; wgid = (xcd < r ? xcd * (q + 1) : r * (q + 1) + (xcd - r) * q) + off; }
        const int nig = WGM * nN, gid = wgid / nig, fm = gid * WGM, gsz = (nM - fm) < WGM ? (nM - fm) : WGM;
        u.pm = fm + ((wgid % nig) % gsz); u.pn = (wgid % nig) / gsz; u.pb = u.pn; return true;
    }
};
struct GroupedOrder {
    int nN, nwg, G, c; const PG8_LAS int* tile_e;
    __device__ void init(int ntiles, int nN_, int G_, int c_, const PG8_LAS int* te) { nN = nN_; nwg = ntiles * nN_; G = G_; c = c_; tile_e = te; }
    __device__ bool next(int i, Unit& u) const {
        const long L = (long)i * G + c; if (L >= nwg) return false;
        int wgid = (int)L; { const int q = nwg / NXCD, r = nwg % NXCD, xcd = wgid % NXCD, off = wgid / NXCD; wgid = (xcd < r ? xcd * (q + 1) : r * (q + 1) + (xcd - r) * q) + off; }
        const int t = wgid / nN; u.pm = t; u.pn = wgid - t * nN; u.pb = __builtin_amdgcn_readfirstlane(tile_e[t]) * nN + u.pn; return true;
    }
};

__device__ __forceinline__ unsigned cvt_pk_bf16(float lo, float hi) { unsigned r; asm volatile("v_cvt_pk_bf16_f32 %0, %1, %2" : "=v"(r) : "v"(lo), "v"(hi)); return r; }

template <bool NT, int WS8 = 0x7F7F7F7F> struct EpiBf16T {
    static constexpr int PERM = 1; static constexpr int NST = 16; static constexpr int WSCALE8 = WS8;
    bf16_t* O; int ldc; int split_cols; size_t split_stride; float scale0;
    __device__ __forceinline__ void operator()(const f32x4 (&acc)[2][2][4][2], const Unit& u, int wr, int wc, int fr, int fq) const {
        const int row0 = u.pm * BM + wr * 64 + fr; int colt = u.pn * BM; bf16_t* base = O;
        float sc = 1.f; if (split_cols) { const int t = colt / split_cols; base += (size_t)t * split_stride; colt -= t * split_cols; if (t == 0) sc = scale0; }
        const int col0 = colt + wc * 32 + 8 * fq;
#pragma unroll
        for (int ai = 0; ai < 2; ++ai)
#pragma unroll
            for (int m = 0; m < 4; ++m) { bf16_t* rowp = base + (size_t)(row0 + ai * HALF + m * 16) * ldc + col0;
#pragma unroll
                for (int bj = 0; bj < 2; ++bj) { f32x4 v0 = acc[ai][bj][m][0] * sc, v1 = acc[ai][bj][m][1] * sc;
                    u32x4 w; w.x = cvt_pk_bf16(v0[0], v0[1]); w.y = cvt_pk_bf16(v0[2], v0[3]); w.z = cvt_pk_bf16(v1[0], v1[1]); w.w = cvt_pk_bf16(v1[2], v1[3]);
                    if constexpr (NT) __builtin_nontemporal_store(w, (u32x4*)(rowp + bj * HALF)); else *(u32x4*)(rowp + bj * HALF) = w; } }
    }
};
typedef EpiBf16T<false> EpiBf16; typedef EpiBf16T<true> EpiBf16NT;
typedef EpiBf16T<false, 0x75757575> EpiBf16A8;
template <int WS8 = 0x7F7F7F7F> struct EpiQKVnT {
    static constexpr int PERM = 1; static constexpr int NST = 16; static constexpr int WSCALE8 = WS8;
    bf16_t* O; size_t split_stride; float scale0; float* nq; float* nk;
    __device__ __forceinline__ void operator()(const f32x4 (&acc)[2][2][4][2], const Unit& u, int wr, int wc, int fr, int fq) const {
        const int row0 = u.pm * BM + wr * 64 + fr; int colt = u.pn * BM; const int t = colt / 2048; bf16_t* base = O + (size_t)t * split_stride; colt -= t * 2048;
        const float sc = t == 0 ? scale0 : 1.f; float* nrm = t == 0 ? nq : nk;
        const int col0 = colt + wc * 32 + 8 * fq;
#pragma unroll
        for (int ai = 0; ai < 2; ++ai)
#pragma unroll
            for (int m = 0; m < 4; ++m) { const int row = row0 + ai * HALF + m * 16; bf16_t* rowp = base + (size_t)row * 2048 + col0;
#pragma unroll
                for (int bj = 0; bj < 2; ++bj) { f32x4 v0 = acc[ai][bj][m][0] * sc, v1 = acc[ai][bj][m][1] * sc;
                    u32x4 w; w.x = cvt_pk_bf16(v0[0], v0[1]); w.y = cvt_pk_bf16(v0[2], v0[3]); w.z = cvt_pk_bf16(v1[0], v1[1]); w.w = cvt_pk_bf16(v1[2], v1[3]);
                    *(u32x4*)(rowp + bj * HALF) = w;
                    if (t < 2) { float ss = (v0[0] * v0[0] + v0[1] * v0[1]) + (v0[2] * v0[2] + v0[3] * v0[3]) + (v1[0] * v1[0] + v1[1] * v1[1]) + (v1[2] * v1[2] + v1[3] * v1[3]);
                        ss += __shfl_xor(ss, 16); ss += __shfl_xor(ss, 32);
                        if (fq == 0) { const int head = (colt >> 7) + bj; atomicAdd(nrm + ((size_t)((row >> 12) * 16 + head) << 12) + (row & 4095), ss); } } } }
    }
};
typedef EpiQKVnT<> EpiQKVn; typedef EpiQKVnT<0x79797979> EpiQKVn8;
struct EpiSwiglu {
    static constexpr int PERM = 1; static constexpr int NST = 8; static constexpr int WSCALE8 = 0x7F7F7F7F;
    bf16_t* O; int ldc;
    __device__ __forceinline__ void operator()(const f32x4 (&acc)[2][2][4][2], const Unit& u, int wr, int wc, int fr, int fq) const {
        const int col0 = u.pn * HALF + wc * 32 + 8 * fq;
#pragma unroll
        for (int ai = 0; ai < 2; ++ai)
#pragma unroll
            for (int m = 0; m < 4; ++m) { bf16_t* rowp = O + (size_t)(u.pm * BM + ai * HALF + wr * 64 + m * 16 + fr) * ldc + col0;
                float a[8];
#pragma unroll
                for (int n = 0; n < 2; ++n)
#pragma unroll
                    for (int j = 0; j < 4; ++j) { const float g = acc[ai][0][m][n][j], up = acc[ai][1][m][n][j];
                        a[n * 4 + j] = g * __builtin_amdgcn_rcpf(1.f + __builtin_amdgcn_exp2f(-1.4426950408889634f * g)) * up; }
                u32x4 w; w.x = cvt_pk_bf16(a[0], a[1]); w.y = cvt_pk_bf16(a[2], a[3]); w.z = cvt_pk_bf16(a[4], a[5]); w.w = cvt_pk_bf16(a[6], a[7]);
                *(u32x4*)rowp = w; }
    }
};
__device__ __forceinline__ unsigned pk4_fp8(float a, float b, float c, float d) { int w = 0; w = __builtin_amdgcn_cvt_pk_fp8_f32(a, b, w, false); w = __builtin_amdgcn_cvt_pk_fp8_f32(c, d, w, true); return (unsigned)w; }
struct EpiFp8Y {
    static constexpr int PERM = 2; static constexpr int NST = 8; static constexpr int WSCALE8 = 0x7D7D7D7D;
    unsigned char* O; int ldc;
    __device__ __forceinline__ void operator()(const f32x4 (&acc)[2][2][4][2], const Unit& u, int wr, int wc, int fr, int fq) const {
        const int col0 = u.pn * BM + wc * 64 + 16 * fq;
#pragma unroll
        for (int ai = 0; ai < 2; ++ai)
#pragma unroll
            for (int m = 0; m < 4; ++m) { unsigned char* rowp = O + (size_t)(u.pm * BM + ai * HALF + wr * 64 + m * 16 + fr) * ldc + col0;
                const f32x4 a = acc[ai][0][m][0], b = acc[ai][0][m][1], c = acc[ai][1][m][0], d = acc[ai][1][m][1];
                u32x4 w; w.x = pk4_fp8(a[0], a[1], a[2], a[3]); w.y = pk4_fp8(b[0], b[1], b[2], b[3]); w.z = pk4_fp8(c[0], c[1], c[2], c[3]); w.w = pk4_fp8(d[0], d[1], d[2], d[3]);
                *(u32x4*)rowp = w; }
    }
};
struct EpiSwiglu8 {
    static constexpr int PERM = 1; static constexpr int NST = 8; static constexpr int WSCALE8 = 0x79797979;
    unsigned char* O; int ldc; float iscale;
    __device__ __forceinline__ void operator()(const f32x4 (&acc)[2][2][4][2], const Unit& u, int wr, int wc, int fr, int fq) const {
        const int col0 = u.pn * HALF + wc * 32 + 8 * fq;
#pragma unroll
        for (int ai = 0; ai < 2; ++ai)
#pragma unroll
            for (int m = 0; m < 4; ++m) { unsigned char* rowp = O + (size_t)(u.pm * BM + ai * HALF + wr * 64 + m * 16 + fr) * ldc + col0;
                float a[8];
#pragma unroll
                for (int n = 0; n < 2; ++n)
#pragma unroll
                    for (int j = 0; j < 4; ++j) { const float g = acc[ai][0][m][n][j] * iscale, up = acc[ai][1][m][n][j] * iscale;
                        a[n * 4 + j] = g * __builtin_amdgcn_rcpf(1.f + __builtin_amdgcn_exp2f(-1.4426950408889634f * g)) * up; }
                u32x2 w; w.x = pk4_fp8(a[0], a[1], a[2], a[3]); w.y = pk4_fp8(a[4], a[5], a[6], a[7]);
                *(u32x2*)rowp = w; }
    }
};
template <int WS8 = 0x7F7F7F7F> struct EpiRopeT {
    static constexpr int PERM = 1; static constexpr int NST = 16; static constexpr int WSCALE8 = WS8;
    bf16_t* Q; bf16_t* Kc; bf16_t* Vc; const float* cs; const float* sn; float qscale;
    __device__ __forceinline__ void operator()(const f32x4 (&acc)[2][2][4][2], const Unit& u, int wr, int wc, int fr, int fq) const {
        if (u.pn == 9) {
#pragma unroll
            for (int ai = 0; ai < 2; ++ai)
#pragma unroll
                for (int m = 0; m < 4; ++m) { bf16_t* rowp = Vc + (size_t)(u.pm * BM + ai * HALF + wr * 64 + m * 16 + fr) * 256 + wc * 32 + 8 * fq;
#pragma unroll
                    for (int bj = 0; bj < 2; ++bj) { const f32x4 v0 = acc[ai][bj][m][0], v1 = acc[ai][bj][m][1];
                        u32x4 w; w.x = cvt_pk_bf16(v0[0], v0[1]); w.y = cvt_pk_bf16(v0[2], v0[3]); w.z = cvt_pk_bf16(v1[0], v1[1]); w.w = cvt_pk_bf16(v1[2], v1[3]);
                        *(u32x4*)(rowp + bj * HALF) = w; } }
            return;
        }
        const bool isq = u.pn < 8; const float sc = isq ? qscale : 1.f;
        bf16_t* base = isq ? Q + u.pn * 256 : Kc; const int ldo = isq ? 2048 : 256;
#pragma unroll
        for (int ai = 0; ai < 2; ++ai)
#pragma unroll
            for (int m = 0; m < 4; ++m) { int fq_ = fq; asm volatile("" : "+v"(fq_)); const int row = u.pm * BM + ai * HALF + wr * 64 + m * 16 + fr; const int pos = row & 4095;
                const unsigned to_ = (unsigned)(pos * 32 + 8 * fq_) * 4u;
                const f32x4 c0 = *(const f32x4*)((const char*)cs + to_), c1 = *(const f32x4*)((const char*)cs + to_ + 16);
                const f32x4 s0 = *(const f32x4*)((const char*)sn + to_), s1 = *(const f32x4*)((const char*)sn + to_ + 16);
                const f32x4 a0 = acc[ai][0][m][0], a1 = acc[ai][0][m][1], b0 = acc[ai][1][m][0], b1 = acc[ai][1][m][1];
                const f32x4 x0 = (a0 * c0 - b0 * s0) * sc, x1 = (a1 * c1 - b1 * s1) * sc, y0 = (b0 * c0 + a0 * s0) * sc, y1 = (b1 * c1 + a1 * s1) * sc;
                bf16_t* rowp = base + (size_t)row * ldo + wc * 64 + 8 * fq_;
                u32x4 w; w.x = cvt_pk_bf16(x0[0], x0[1]); w.y = cvt_pk_bf16(x0[2], x0[3]); w.z = cvt_pk_bf16(x1[0], x1[1]); w.w = cvt_pk_bf16(x1[2], x1[3]);
                *(u32x4*)rowp = w;
                w.x = cvt_pk_bf16(y0[0], y0[1]); w.y = cvt_pk_bf16(y0[2], y0[3]); w.z = cvt_pk_bf16(y1[0], y1[1]); w.w = cvt_pk_bf16(y1[2], y1[3]);
                *(u32x4*)(rowp + 32) = w;
                if (m & 1) asm volatile("" ::: "memory"); }
    }
};
typedef EpiRopeT<> EpiRope; typedef EpiRopeT<0x79797979> EpiRope8;

__device__ __forceinline__ void glds16s(const void* sbase, unsigned voff, unsigned lds_dst) { unsigned keep;
    asm volatile("s_mov_b32 %0, m0\n\ts_mov_b32 m0, %3\n\ts_nop 0\n\tglobal_load_lds_dwordx4 %1, %2\n\ts_mov_b32 m0, %0" : "=&s"(keep) : "v"(voff), "s"(sbase), "s"(lds_dst) : "memory"); }
template <class Epi, class Sched, bool ALIGN_EPI, bool GATHER, bool FP8 = false>
__device__ __forceinline__ void gemm_phase(PG8_LAS unsigned char* lds, const Gemm g, const Sched& S, const Epi& E) {
    const int tid = threadIdx.x, wid = __builtin_amdgcn_readfirstlane(tid >> 6), lane = tid & 63, wr = wid >> 2, wc = wid & 3, fr = lane & 15, fq = lane >> 4;
    int K = g.K; if constexpr (FP8) asm volatile("" : "+s"(K)); const int nt = K / BK;
    unsigned voffB[2][2], vcur[2][2], vnxt[2][2];
    constexpr int PM = (int)Epi::PERM;
#pragma unroll
    for (int i = 0; i < 2; ++i) { int R, C; stage_rc(tid * 16 + i * 8192, R, C);
        if constexpr (PM == 2) { const int w_ = R >> 5, n_ = (R >> 4) & 1, q_ = (R >> 2) & 3, r_ = R & 3;
#pragma unroll
            for (int h = 0; h < 2; ++h) voffB[h][i] = (unsigned)((64 * w_ + 16 * q_ + 8 * h + 4 * n_ + r_) * K + C) * 2u; }
        else { const int Rb = PM ? ((R & ~31) + perm32(R & 31)) : R; voffB[0][i] = (unsigned)(Rb * K + C) * 2u; voffB[1][i] = voffB[0][i] + (unsigned)(HALF * K * 2); } }
    const size_t kstep = (size_t)(BK * 2);
    const size_t hstep = (size_t)HALF * K * 2;
    const size_t tstep = 2 * hstep;
    const unsigned ldsw = (unsigned)wid * 1024u; const unsigned ldsa = (unsigned)__builtin_amdgcn_readfirstlane((int)((unsigned)(uintptr_t)lds + (unsigned)wid * 1024u));
    const int aoff = lds_byte(wr * 64 + fr, fq * 8), boff = lds_byte(wc * 32 + fr, fq * 8);
#define PG8_SA(b, h) (((b) * 2 + (h)) * HTB)
#define PG8_SB(b, h) ((4 + (b) * 2 + (h)) * HTB)
#define PG8_STAGE(bufoff, gbase, voff) do { _Pragma("unroll") for (int _i = 0; _i < 2; ++_i) { \
        glds16s((const void*)(gbase), (voff)[_i], ldsa + (unsigned)((bufoff) + _i * 8192)); } } while (0)
#define PG8_STAGE_A1(bufoff, gbase, voff2) do { if constexpr (GATHER) PG8_STAGE(bufoff, gbase, (voff2)[1]); else PG8_STAGE(bufoff, (gbase) + hstep, (voff2)[0]); } while (0)
#define PG8_STAGE_B1(bufoff, gbase) do { if constexpr (PM == 2) PG8_STAGE(bufoff, gbase, voffB[1]); else PG8_STAGE(bufoff, (gbase) + hstep, voffB[0]); } while (0)
#define PG8_LDA(dst, b, h) do { _Pragma("unroll") for (int m = 0; m < 4; ++m) _Pragma("unroll") for (int k = 0; k < 2; ++k) dst[m][k] = *(const PG8_LAS bf16x8*)(lds + PG8_SA(b, h) + aoff + m * 2048 + k * 1024); } while (0)
#define PG8_LDB(dst, b, h) do { _Pragma("unroll") for (int n = 0; n < 2; ++n) _Pragma("unroll") for (int k = 0; k < 2; ++k) dst[n][k] = *(const PG8_LAS bf16x8*)(lds + PG8_SB(b, h) + boff + n * 2048 + k * 1024); } while (0)
#define PG8_CAT8(x) __builtin_bit_cast(v8i, __builtin_shufflevector((x)[0], (x)[1], 0, 1, 2, 3, 4, 5, 6, 7, 8, 9, 10, 11, 12, 13, 14, 15))
#define PG8_MMA(ZC, ai, bj, At, Bt) do { __builtin_amdgcn_s_setprio(1); _Pragma("unroll") for (int m = 0; m < 4; ++m) _Pragma("unroll") for (int n = 0; n < 2; ++n) { \
        if constexpr (FP8) { if constexpr (ZC) asm volatile("v_mfma_scale_f32_16x16x128_f8f6f4 %0, %1, %2, 0, %3, %4 op_sel_hi:[0,0,0]" : "=&v"(acc[ai][bj][m][n]) : "v"(PG8_CAT8(Bt[n])), "v"(PG8_CAT8(At[m])), "v"(sc8w), "v"(sc8)); \
            else asm volatile("v_mfma_scale_f32_16x16x128_f8f6f4 %0, %1, %2, %0, %3, %4 op_sel_hi:[0,0,0]" : "+v"(acc[ai][bj][m][n]) : "v"(PG8_CAT8(Bt[n])), "v"(PG8_CAT8(At[m])), "v"(sc8w), "v"(sc8)); } \
        else { acc[ai][bj][m][n] = __builtin_amdgcn_mfma_f32_16x16x32_bf16(Bt[n][0], At[m][0], (ZC) ? (f32x4){0.f, 0.f, 0.f, 0.f} : acc[ai][bj][m][n], 0, 0, 0); \
               acc[ai][bj][m][n] = __builtin_amdgcn_mfma_f32_16x16x32_bf16(Bt[n][1], At[m][1], acc[ai][bj][m][n], 0, 0, 0); } } __builtin_amdgcn_s_setprio(0); } while (0)
#define PG8_WAIT_V(n) asm volatile("s_waitcnt vmcnt(" #n ")" ::: "memory")
#define PG8_WAIT_VN(n) asm volatile("s_waitcnt vmcnt(%0)" :: "i"(n) : "memory")
#define PG8_WAIT_L(n) asm volatile("s_waitcnt lgkmcnt(" #n ")" ::: "memory")
#define PG8_BAR __builtin_amdgcn_s_barrier()
#define PG8_SCHED __builtin_amdgcn_sched_barrier(0)
#define PG8_AOFFS(dst, u_) do { _Pragma("unroll") for (int _h = 0; _h < 2; ++_h) _Pragma("unroll") for (int _i = 0; _i < 2; ++_i) { int R_, C_; stage_rc(tid * 16 + _i * 8192, R_, C_); \
        if constexpr (GATHER) dst[_h][_i] = (unsigned)g.rowtab[(u_).pm * BM + _h * HALF + R_] * (unsigned)(K * 2) + (unsigned)C_ * 2u; \
        else dst[_h][_i] = (unsigned)(R_ * K) * 2u + (unsigned)C_ * 2u + (unsigned)(_h * hstep); } } while (0)
    constexpr int RT_OFF = 135168;
#define PG8_AOFFS_L(dst) do { _Pragma("unroll") for (int _h = 0; _h < 2; ++_h) _Pragma("unroll") for (int _i = 0; _i < 2; ++_i) { int R_, C_; stage_rc(tid * 16 + _i * 8192, R_, C_); \
        dst[_h][_i] = (unsigned)((const PG8_LAS int*)(lds + RT_OFF))[_h * HALF + R_] * (unsigned)(K * 2) + (unsigned)C_ * 2u; } } while (0)
    Unit cur, nxt; int ui = 0;
    if (!S.next(0, cur)) return;
    f32x4 acc[2][2][4][2];
#pragma unroll
    for (int a = 0; a < 2; ++a)
#pragma unroll
        for (int b = 0; b < 2; ++b)
#pragma unroll
            for (int m = 0; m < 4; ++m)
#pragma unroll
                for (int n = 0; n < 2; ++n) acc[a][b][m][n] = (f32x4){0.f, 0.f, 0.f, 0.f};
    bf16x8 At[4][2], B0[2][2], B1[2][2]; const int sc8 = 0x7F7F7F7F; int sc8w = 0x7F7F7F7F; if constexpr (FP8) sc8w = Epi::WSCALE8;
    PG8_AOFFS(vcur, cur);
    const char* cA = GATHER ? (const char*)g.A : (const char*)g.A + (size_t)cur.pm * tstep; const char* cB = (const char*)g.Bt + (size_t)cur.pb * tstep;
    PG8_STAGE(PG8_SB(0, 0), cB, voffB[0]); PG8_STAGE_B1(PG8_SB(0, 1), cB); PG8_STAGE(PG8_SA(0, 0), cA, vcur[0]); PG8_STAGE_A1(PG8_SA(0, 1), cA, vcur);
    if (wr == 1) PG8_BAR;
    PG8_WAIT_V(2); PG8_BAR;
    PG8_STAGE(PG8_SB(1, 0), cB + kstep, voffB[0]); PG8_STAGE(PG8_SA(1, 0), cA + kstep, vcur[0]); PG8_STAGE_B1(PG8_SB(1, 1), cB + kstep); PG8_STAGE_A1(PG8_SA(1, 1), cA + kstep, vcur);
    PG8_WAIT_V(0); PG8_BAR;
    for (;;) {
        const bool has_next = S.next(ui + 1, nxt);
        const char* nA = GATHER ? (const char*)g.A : (has_next ? (const char*)g.A + (size_t)nxt.pm * tstep : cA); const char* nB = has_next ? (const char*)g.Bt + (size_t)nxt.pb * tstep : cB;
#pragma unroll
        for (int _h = 0; _h < 2; ++_h)
#pragma unroll
            for (int _i = 0; _i < 2; ++_i) vnxt[_h][_i] = vcur[_h][_i];
        if constexpr (GATHER) { if (has_next && wid == 0) glds16s((const void*)(g.rowtab + (size_t)nxt.pm * BM), (unsigned)lane * 16u, (unsigned)(uintptr_t)lds + (unsigned)RT_OFF); }
#define PG8_TRIP(FIRST, t_) do { const int t = (t_); const bool last = (t == nt - 2); \
            if constexpr (GATHER) { if (last && has_next) { PG8_AOFFS_L(vnxt); } }     \
            const char* a1 = cA + (size_t)(t + 1) * kstep; \
            const char* a2 = last ? nA : cA + (size_t)(t + 2) * kstep; const char* b2 = last ? nB : cB + (size_t)(t + 2) * kstep; \
            const char* a3 = a2 + kstep; const char* b3 = b2 + kstep; \
            unsigned s0[2], s1[2]; \
            _Pragma("unroll") for (int _i = 0; _i < 2; ++_i) { if constexpr (GATHER) { s0[_i] = last ? vnxt[0][_i] : vcur[0][_i]; s1[_i] = last ? vnxt[1][_i] : vcur[1][_i]; } else { s0[_i] = vcur[0][_i]; s1[_i] = vcur[1][_i]; } } \
              \
            PG8_LDB(B0, 0, 0); PG8_LDB(B1, 0, 1); PG8_SCHED; PG8_LDA(At, 0, 0); if constexpr (!(FIRST)) { PG8_STAGE_A1(PG8_SA(1, 1), a1, vcur); PG8_WAIT_V(8); } \
            PG8_WAIT_L(0); PG8_BAR; PG8_MMA(FIRST, 0, 0, At, B0); PG8_MMA(FIRST, 0, 1, At, B1); PG8_BAR; PG8_SCHED; \
              \
            PG8_LDA(At, 0, 1); PG8_STAGE(PG8_SB(0, 0), b2, voffB[0]); PG8_STAGE_B1(PG8_SB(0, 1), b2); PG8_STAGE(PG8_SA(0, 0), a2, s0); \
            if constexpr (FIRST) PG8_WAIT_VN(8 + Epi::NST); else PG8_WAIT_V(8); \
            PG8_WAIT_L(0); PG8_BAR; PG8_MMA(FIRST, 1, 0, At, B0); PG8_MMA(FIRST, 1, 1, At, B1); PG8_BAR; PG8_SCHED; \
              \
            PG8_LDB(B0, 1, 0); PG8_LDB(B1, 1, 1); PG8_SCHED; PG8_LDA(At, 1, 0); if constexpr (GATHER) PG8_STAGE(PG8_SA(0, 1), a2, s1); else PG8_STAGE(PG8_SA(0, 1), (a2) + hstep, s0); \
            if constexpr (FIRST) PG8_WAIT_VN(8 + Epi::NST); else PG8_WAIT_V(8); \
            PG8_WAIT_L(0); PG8_BAR; PG8_MMA(false, 0, 0, At, B0); PG8_MMA(false, 0, 1, At, B1); PG8_BAR; PG8_SCHED; \
              \
            PG8_LDA(At, 1, 1); PG8_STAGE(PG8_SB(1, 0), b3, voffB[0]); PG8_STAGE_B1(PG8_SB(1, 1), b3); PG8_STAGE(PG8_SA(1, 0), a3, s0); \
            PG8_WAIT_V(8); PG8_WAIT_L(0); PG8_BAR; PG8_MMA(false, 1, 0, At, B0); PG8_MMA(false, 1, 1, At, B1); PG8_BAR; PG8_SCHED; } while (0)
        PG8_TRIP(true, 0);
        for (int tt = 2; tt < nt; tt += 2) PG8_TRIP(false, tt);
        if constexpr (FP8) asm volatile("s_nop 15\n\ts_nop 15" ::: "memory");
        if constexpr (ALIGN_EPI) { if (wr == 0) PG8_BAR; }
        static_assert(ALIGN_EPI, "the pre-epilogue piece below needs both halves past their last LDS reads");
        if (has_next) { if constexpr (GATHER) PG8_STAGE(PG8_SA(1, 1), nA + kstep, vnxt[1]); else PG8_STAGE(PG8_SA(1, 1), nA + kstep + hstep, vcur[0]); }
        E(acc, cur, wr, wc, fr, fq);
        if (!has_next) break;
        cur = nxt; cA = nA; cB = nB; ++ui;
#pragma unroll
        for (int _h = 0; _h < 2; ++_h)
#pragma unroll
            for (int _i = 0; _i < 2; ++_i) vcur[_h][_i] = vnxt[_h][_i];
        if constexpr (ALIGN_EPI) { if (wr == 1) PG8_BAR; }
    }
    PG8_WAIT_V(0);
    if constexpr (!ALIGN_EPI) { if (wr == 0) PG8_BAR; }
    PG8_BAR;
#undef PG8_SA
#undef PG8_SB
#undef PG8_STAGE
#undef PG8_LDA
#undef PG8_STAGE_A1
#undef PG8_STAGE_B1
#undef PG8_LDB
#undef PG8_MMA
#undef PG8_CAT8
#undef PG8_WAIT_V
#undef PG8_WAIT_VN
#undef PG8_WAIT_L
#undef PG8_BAR
#undef PG8_SCHED
#undef PG8_AOFFS
#undef PG8_AOFFS_L
#undef PG8_TRIP
}
}
#ifndef FOX_DOUBLE
#define FOX_DOUBLE 0
#endif
namespace fox {
constexpr bool O8 = (ATT8_MASK & 4) != 0;
using bf16 = __hip_bfloat16;
typedef short bf16x8 __attribute__((ext_vector_type(8)));
typedef short s16x4 __attribute__((ext_vector_type(4)));
typedef float f32x16 __attribute__((ext_vector_type(16)));
typedef float f32x4 __attribute__((ext_vector_type(4)));
typedef unsigned u32x4 __attribute__((ext_vector_type(4)));
constexpr int D = 128, LDQ = 2048, SEQ = 4096, NH = 16, NB = 4;
constexpr int NW = 8, QBLK = 32, KVBLK = 64, QB = NW * QBLK;
constexpr int SHM_V = KVBLK * D * 2, SHM_K = KVBLK * D * 2;
constexpr int OFF_WS = 2 * SHM_V + 2 * SHM_K, OFF_CB = OFF_WS + NW * 64 * 4, LDS_BYTES = OFF_CB + 2 * 64 * 4;
constexpr float THRL = 11.5f;

#define KSWZ(row, colB) ((row) * 256 + ((colB) ^ (((row) & 7) << 4)))
#define SBAR() __builtin_amdgcn_sched_barrier(0)
__device__ __forceinline__ int v_st(int k, int c) { const int kk = (k & ~0xC) | ((k & 4) << 1) | ((k & 8) >> 1); return ((kk >> 3) * 4 + (c >> 5)) * 512 + ((kk & 7) * 32 + (c & 31)) * 2; }
__device__ __forceinline__ int v_rd_base(int lane) { return ((lane & 3) << 3) | (((lane >> 2) & 3) << 6) | (((lane >> 4) & 1) << 5) | (((lane >> 5) & 1) << 8); }
constexpr int v_rd_off(int d0, int ks, int half) { return d0 * 512 + ks * 4096 + half * 2048; }
__device__ __forceinline__ int crow(int r, int hi) { return (r & 3) + 8 * (r >> 2) + 4 * hi; }
__device__ __forceinline__ unsigned cvtpk(float lo, float hi) {
    unsigned r; asm volatile("v_cvt_pk_bf16_f32 %0, %1, %2" : "=v"(r) : "v"(lo), "v"(hi)); return r;
}
__device__ __forceinline__ bf16x8 load8(const bf16* p) { return *reinterpret_cast<const bf16x8*>(p); }
__device__ __forceinline__ void mask_tile(f32x16& p0, f32x16& p1, int dq) {
    const float NEG = -__builtin_inff();
#pragma unroll
    for (int r = 0; r < 16; ++r) {
        const int c = (r & 3) + 8 * (r >> 2);
        if (dq - c < 0) p0[r] = NEG;
        if (dq - c - 32 < 0) p1[r] = NEG;
    }
}
__device__ __forceinline__ void partialSM(f32x16& p0, f32x16& p1, float& m_reg, float& mn, float& alpha) {
    float pmax = p0[0]; for (int r = 1; r < 16; ++r) pmax = fmaxf(pmax, p0[r]); for (int r = 0; r < 16; ++r) pmax = fmaxf(pmax, p1[r]);
    { auto rr = __builtin_amdgcn_permlane32_swap(__float_as_uint(pmax), __float_as_uint(pmax), false, false);
      pmax = fmaxf(__uint_as_float(rr[0]), __uint_as_float(rr[1])); }
    if (__builtin_expect(__all((pmax - m_reg) <= THRL), 1)) { mn = m_reg; alpha = 1.f; }
    else { mn = fmaxf(m_reg, pmax); alpha = __builtin_amdgcn_exp2f(m_reg - mn); m_reg = mn; }
    for (int r = 0; r < 16; ++r) p0[r] = p0[r] - mn; for (int r = 0; r < 16; ++r) p1[r] = p1[r] - mn;
    for (int r = 0; r < 16; ++r) p0[r] = __builtin_amdgcn_exp2f(p0[r]);
}
__device__ __forceinline__ void finishSM(f32x16& p0, f32x16& p1, float alpha, float& l_reg, bf16x8& pa0, bf16x8& pa1, bf16x8& pa2, bf16x8& pa3) {
    for (int r = 0; r < 16; ++r) p1[r] = __builtin_amdgcn_exp2f(p1[r]);
    float ps = 0; for (int r = 0; r < 16; ++r) ps += p0[r]; for (int r = 0; r < 16; ++r) ps += p1[r];
    { auto rr = __builtin_amdgcn_permlane32_swap(__float_as_uint(ps), __float_as_uint(ps), false, false);
      ps = __uint_as_float(rr[0]) + __uint_as_float(rr[1]); }
    l_reg = l_reg * alpha + ps;
#define PK4(P, B_, OUT) do { unsigned a0 = cvtpk(P[B_+0], P[B_+1]), a1 = cvtpk(P[B_+2], P[B_+3]);                          \
        unsigned b0 = cvtpk(P[B_+4], P[B_+5]), b1 = cvtpk(P[B_+6], P[B_+7]);                                             \
        auto r0 = __builtin_amdgcn_permlane32_swap(a0, b0, false, false); auto r1 = __builtin_amdgcn_permlane32_swap(a1, b1, false, false); \
        u32x4 w = {r0[0], r1[0], r0[1], r1[1]}; OUT = *reinterpret_cast<bf16x8*>(&w); } while (0)
    PK4(p0, 0, pa0); PK4(p0, 8, pa1); PK4(p1, 0, pa2); PK4(p1, 8, pa3);
#undef PK4
}
template <int KB>
__device__ __forceinline__ void qkt(f32x16& p0, f32x16& p1, const char* K_lds, const float* cbl, int r32, int hi, const bf16x8* qr) {
    const float* cb = cbl + KB * 64 + 4 * hi;
#pragma unroll
    for (int g = 0; g < 4; ++g) { const f32x4 a = *(const f32x4*)(cb + 8 * g), b = *(const f32x4*)(cb + 32 + 8 * g);
        p0[4 * g + 0] = a[0]; p0[4 * g + 1] = a[1]; p0[4 * g + 2] = a[2]; p0[4 * g + 3] = a[3];
        p1[4 * g + 0] = b[0]; p1[4 * g + 1] = b[1]; p1[4 * g + 2] = b[2]; p1[4 * g + 3] = b[3]; }
    const char* kb[4];
#pragma unroll
    for (int dd = 0; dd < 4; ++dd) kb[dd] = K_lds + KB * SHM_K + KSWZ(r32, (dd * 16 + hi * 8) * 2);
#pragma unroll
    for (int d0 = 0; d0 < 8; ++d0) { const char* a = kb[d0 & 3] + (d0 >> 2) * 128;
        bf16x8 b0 = *reinterpret_cast<const bf16x8*>(a);
        bf16x8 b1 = *reinterpret_cast<const bf16x8*>(a + 32 * 256);
        p0 = __builtin_amdgcn_mfma_f32_32x32x16_bf16(b0, qr[d0], p0, 0, 0, 0);
        p1 = __builtin_amdgcn_mfma_f32_32x32x16_bf16(b1, qr[d0], p1, 0, 0, 0); }
}
template <int VB>
__device__ __forceinline__ void pv_tile(f32x16* o, int vb0, bf16x8 pa0, bf16x8 pa1, bf16x8 pa2, bf16x8 pa3) {
#define TRRD(dst, off) asm volatile("ds_read_b64_tr_b16 %0, %1 offset:%2" : "=&v"(dst) : "v"(vb0), "i"(off) : "memory")
#define PV_D0(d0) do { s16x4 l0, l1, l2, l3, h0, h1, h2, h3; constexpr int b_ = VB * SHM_V + v_rd_off(d0, 0, 0);     \
        TRRD(l0, b_); TRRD(h0, b_ + 2048); TRRD(l1, b_ + 4096); TRRD(h1, b_ + 6144); TRRD(l2, b_ + 8192); TRRD(h2, b_ + 10240); TRRD(l3, b_ + 12288); TRRD(h3, b_ + 14336); \
        asm volatile("s_waitcnt lgkmcnt(0)" ::: "memory"); SBAR();                                                              \
        o[d0] = __builtin_amdgcn_mfma_f32_32x32x16_bf16(pa0, (bf16x8){l0[0], l0[1], l0[2], l0[3], h0[0], h0[1], h0[2], h0[3]}, o[d0], 0, 0, 0);   \
        o[d0] = __builtin_amdgcn_mfma_f32_32x32x16_bf16(pa1, (bf16x8){l1[0], l1[1], l1[2], l1[3], h1[0], h1[1], h1[2], h1[3]}, o[d0], 0, 0, 0);   \
        o[d0] = __builtin_amdgcn_mfma_f32_32x32x16_bf16(pa2, (bf16x8){l2[0], l2[1], l2[2], l2[3], h2[0], h2[1], h2[2], h2[3]}, o[d0], 0, 0, 0);   \
        o[d0] = __builtin_amdgcn_mfma_f32_32x32x16_bf16(pa3, (bf16x8){l3[0], l3[1], l3[2], l3[3], h3[0], h3[1], h3[2], h3[3]}, o[d0], 0, 0, 0); } while (0)
    PV_D0(0); PV_D0(1); PV_D0(2); PV_D0(3);
#undef PV_D0
#undef TRRD
}

struct BlockRef { const bf16* Q; const bf16* K; const bf16* V; bf16* O; const float* C; int P0, jlo; };
struct Seam { bf16x8 qr[8]; bf16x8 st_v0, st_v1, st_k0, st_k1; float st_c; };
#define ROW(p, k0, rr) ((p) + (size_t)((k0) + (rr)) * LDQ + sc)
#define VMW() asm volatile("s_waitcnt vmcnt(0)" ::: "memory")
#define VMWN(n) asm volatile("s_waitcnt vmcnt(%0)" :: "i"(n) : "memory")
#define SLOAD_H(Kp, Vp, Cp, cr, k0) do { const char* kb_ = (const char*)(Kp) + (size_t)(k0) * (LDQ * 2); const char* vb_ = (const char*)(Vp) + (size_t)(k0) * (LDQ * 2);     \
                         int u_ = threadIdx.x; asm volatile("" : "+v"(u_)); const unsigned voffA = (unsigned)((u_ >> 4) * LDQ + (u_ & 15) * 8) * 2u, voffB = voffA + 32u * LDQ * 2u; \
                         S.st_v0 = *(const bf16x8*)(vb_ + voffA); S.st_v1 = *(const bf16x8*)(vb_ + voffB);              \
                         S.st_k0 = *(const bf16x8*)(kb_ + voffA); S.st_k1 = *(const bf16x8*)(kb_ + voffB); S.st_c = (Cp)[(k0) + (u_ & 63)] - (cr); } while (0)
#define SWRITE_HK(bf) do { int t_ = threadIdx.x; asm volatile("" : "+v"(t_)); const int sr_ = t_ >> 4, sc_ = (t_ & 15) * 8, kws_ = KSWZ(sr_, sc_ * 2); \
        *(bf16x8*)(K_lds + (bf) * SHM_K + kws_) = S.st_k0; *(bf16x8*)(K_lds + (bf) * SHM_K + kws_ + 32 * 256) = S.st_k1; cbl[(bf) * 64 + (t_ & 63)] = S.st_c; } while (0)
#define SWRITE_HV(bf) do { int t_ = threadIdx.x; asm volatile("" : "+v"(t_)); const int sr_ = t_ >> 4, sc_ = (t_ & 15) * 8; \
        *(bf16x8*)(V_lds + (bf) * SHM_V + v_st(sr_, sc_)) = S.st_v0; *(bf16x8*)(V_lds + (bf) * SHM_V + v_st(32 + sr_, sc_)) = S.st_v1; } while (0)
#define SWRITE_H(bf) do { SWRITE_HV(bf); SWRITE_HK(bf); } while (0)
__device__ __forceinline__ void fox_prime(const BlockRef& cur, char* lds, Seam& S) {
    const int tid = threadIdx.x, wid = __builtin_amdgcn_readfirstlane(tid >> 6), lane = tid & 63, r32 = lane & 31, hi = lane >> 5;
    const int sr = tid >> 4, sc = (tid & 15) * 8, kws = KSWZ(sr, sc * 2); char* K_lds = lds + 2 * SHM_V; float* cbl = (float*)(lds + OFF_CB);
    const float cref = cur.C[cur.P0 + QB - 1];
    for (int d0 = 0; d0 < 8; ++d0) S.qr[d0] = load8(cur.Q + (size_t)(wid * QBLK + r32) * LDQ + d0 * 16 + hi * 8);
    SLOAD_H(cur.K, cur.V, cur.C, cref, cur.jlo * KVBLK); VMW(); SWRITE_HK(0);
    __syncthreads();
}
__device__ __forceinline__ void fox_block(const BlockRef& cur, const BlockRef& nxt, char* lds, Seam& S) {
    const int tid = threadIdx.x, wid = __builtin_amdgcn_readfirstlane(tid >> 6), lane = tid & 63, r32 = lane & 31, hi = lane >> 5;
    const int j_lo = cur.jlo, NT = (cur.P0 + QB - 1) / KVBLK + 1 - j_lo;
    const int qlo = cur.P0 + wid * QBLK, qm = qlo + r32 - 4 * hi;
    char* V_lds = lds; char* K_lds = lds + 2 * SHM_V; float* cbl = (float*)(lds + OFF_CB);
    float* ws = (float*)(lds + OFF_WS) + wid * 64; float* li_l = ws, * al_l = ws + 32;
    float l_reg = 0; f32x16 o[4] = {};
    const int sr = tid >> 4, sc = (tid & 15) * 8, vst0 = v_st(sr, sc), vst1 = v_st(32 + sr, sc), kws = KSWZ(sr, sc * 2);
    const int vb0 = (int)(uintptr_t)V_lds + v_rd_base(lane);
    const bf16* Kh = cur.K; const bf16* Vh = cur.V; const float* Ch = cur.C;
    const float cref = Ch[cur.P0 + QB - 1], crefn = nxt.C[nxt.P0 + QB - 1];
    float m_reg = Ch[qlo + r32] - cref - 4.0f;
#define RESC(a) do { if (__any((a) < 1.f)) { if (hi == 0) al_l[r32] = (a); asm volatile("s_waitcnt lgkmcnt(0)" ::: "memory");              \
                     for (int d_ = 0; d_ < 4; ++d_) for (int r = 0; r < 16; ++r) o[d_][r] *= al_l[crow(r, hi)]; } } while (0)
#define KBASE(t) ((j_lo + (t)) * KVBLK)
#define MASKT(P0_, P1_, t) do { const int kb_ = KBASE(t); if (kb_ + KVBLK - 1 > qlo) mask_tile(P0_, P1_, qm - kb_); } while (0)
    constexpr int NQL = 8;
#define SEAM_K0() do { VMWN(NQL); SWRITE_HK(0); SBAR(); } while (0)
    f32x16 pA0, pA1, pB0, pB1; float mnA, mnB, alA, alB; bf16x8 pa0, pa1, pa2, pa3;
    SWRITE_HV(0); SBAR();
    if (NT > 1) { SLOAD_H(Kh, Vh, Ch, cref, KBASE(1)); }
    SBAR(); qkt<0>(pA0, pA1, K_lds, cbl, r32, hi, S.qr);
    MASKT(pA0, pA1, 0); partialSM(pA0, pA1, m_reg, mnA, alA);
    if (NT > 1) { VMW(); SWRITE_H(1); }
    __syncthreads();
#define HALF_STEP(PX0, PX1, mnX, alX, PY0, PY1, alY, t, KB, VB, SB) do {                                                      \
        SBAR(); qkt<KB>(PX0, PX1, K_lds, cbl, r32, hi, S.qr);                                                                 \
        finishSM(PY0, PY1, alY, l_reg, pa0, pa1, pa2, pa3); SBAR();                                                           \
        if ((t) + 1 < NT) { SLOAD_H(Kh, Vh, Ch, cref, KBASE((t) + 1)); SBAR(); }                                              \
        pv_tile<VB>(o, vb0, pa0, pa1, pa2, pa3); MASKT(PX0, PX1, (t)); partialSM(PX0, PX1, m_reg, mnX, alX);                  \
        __syncthreads();                                                                                                      \
        if ((t) + 1 < NT) { VMW(); SWRITE_H(SB); }                                                                            \
        RESC(alX); __syncthreads(); } while (0)
    for (int t = 1; t + 1 < NT; t += 2) {
        HALF_STEP(pB0, pB1, mnB, alB, pA0, pA1, alA, t, 1, 0, 0);
        HALF_STEP(pA0, pA1, mnA, alA, pB0, pB1, alB, t + 1, 0, 1, 1);
    }
    const bool even = (NT & 1) == 0;
    if (even) { SBAR(); qkt<1>(pB0, pB1, K_lds, cbl, r32, hi, S.qr); SBAR(); }
    SLOAD_H(nxt.K, nxt.V, nxt.C, crefn, nxt.jlo * KVBLK); SBAR();
#pragma unroll
    for (int d0 = 0; d0 < 8; ++d0) S.qr[d0] = load8(nxt.Q + (size_t)(wid * QBLK + r32) * LDQ + d0 * 16 + hi * 8);
    SBAR();
    finishSM(pA0, pA1, alA, l_reg, pa0, pa1, pa2, pa3); SBAR();
    pv_tile<0>(o, vb0, pa0, pa1, pa2, pa3);
    if (even) { MASKT(pB0, pB1, NT - 1); partialSM(pB0, pB1, m_reg, mnB, alB); __syncthreads(); RESC(alB);
        finishSM(pB0, pB1, alB, l_reg, pa0, pa1, pa2, pa3); SBAR(); pv_tile<1>(o, vb0, pa0, pa1, pa2, pa3); }
    SBAR(); SEAM_K0();
    if (hi == 0) li_l[r32] = l_reg; asm volatile("s_waitcnt lgkmcnt(0)" ::: "memory");
    float rli[16];
#pragma unroll
    for (int r = 0; r < 16; ++r) rli[r] = __builtin_amdgcn_rcpf(li_l[crow(r, hi)]) * (O8 ? 16.f : 1.f);
    bf16* Ow = cur.O + (size_t)(wid * QBLK) * LDQ; unsigned char* Ow8 = (unsigned char*)cur.O + (size_t)(wid * QBLK) * LDQ;
#pragma unroll
    for (int r = 0; r < 16; ++r) { const int orow = crow(r, hi);
#pragma unroll
        for (int d0 = 0; d0 < 4; ++d0) { const float v = o[d0][r] * rli[r];
            const float vn = __shfl_xor(v, 1);
            if ((r32 & 1) == 0) { if constexpr (O8) *(unsigned short*)(Ow8 + (size_t)orow * LDQ + d0 * 32 + r32) = (unsigned short)__builtin_amdgcn_cvt_pk_fp8_f32(v, vn, 0, false);
                else *(unsigned*)(Ow + (size_t)orow * LDQ + d0 * 32 + r32) = cvtpk(v, vn); } } }
    __syncthreads();
#undef RESC
#undef KBASE
#undef MASKT
#undef SEAM_K0
#undef HALF_STEP
}
#undef ROW
#undef VMW
#undef VMWN
#undef SLOAD_H
#undef SWRITE_HK
#undef SWRITE_HV
#undef SWRITE_H
#undef KSWZ
#undef SBAR

__device__ __forceinline__ int dq(char* lds, unsigned* ctr) {
    volatile __attribute__((address_space(3))) int* sq = (volatile __attribute__((address_space(3))) int*)(lds + LDS_BYTES);
    __syncthreads();
    if (threadIdx.x == 0) sq[0] = (int)__hip_atomic_fetch_add(ctr, 1u, __ATOMIC_RELAXED, __HIP_MEMORY_SCOPE_AGENT);
    __syncthreads();
    return __builtin_amdgcn_readfirstlane(sq[0]);
}
__device__ __forceinline__ BlockRef ref(int L, const bf16* Q, const bf16* K, const bf16* V, bf16* O, const float* CB, const int* jtab) {
    L &= 1023; const int bh = L & 63, qb = 15 - (L >> 6), b = bh >> 4, h = bh & 15; const size_t rowb = (size_t)b * SEQ;
    BlockRef r; r.Q = Q + (rowb + (size_t)qb * QB) * LDQ + h * D; { const size_t oo = (rowb + (size_t)qb * QB) * LDQ + h * D; r.O = O8 ? (bf16*)((unsigned char*)O + oo) : O + oo; }
    r.K = K + rowb * LDQ + h * D; r.V = V + rowb * LDQ + h * D; r.C = CB + (size_t)bh * SEQ; r.P0 = qb * QB; r.jlo = __builtin_amdgcn_readfirstlane(jtab[L]); return r;
}
__device__ __forceinline__ void fox_jlo_item(char* lds, int L, const float* CB, const float* qn2, const float* kn2, int* jtab) {
    const int tid = threadIdx.x, lane = tid & 63, wid = tid >> 6;
    volatile __attribute__((address_space(3))) float* sf = (volatile __attribute__((address_space(3))) float*)(lds + 64);
    const int bh = L & 63, qb = 15 - (L >> 6), P0 = qb * QB;
    float qm = 0.f, km = 0.f;
    if (tid < QB) qm = qn2[(size_t)bh * SEQ + P0 + tid];
    { float kv[SEQ / (NW * 64)];
#pragma unroll
      for (int u = 0; u < SEQ / (NW * 64); ++u) { const int j = tid + NW * 64 * u; kv[u] = (j < P0 + QB) ? kn2[(size_t)bh * SEQ + j] : 0.f; }
#pragma unroll
      for (int u = 0; u < SEQ / (NW * 64); ++u) km = fmaxf(km, kv[u]); }
#pragma unroll
    for (int o = 1; o < 64; o <<= 1) { qm = fmaxf(qm, __shfl_xor(qm, o)); km = fmaxf(km, __shfl_xor(km, o)); }
    __syncthreads();
    if (lane == 0) { sf[wid] = qm; sf[8 + wid] = km; }
    __syncthreads();
    if (tid < 64) {
        float q2 = 0.f, k2 = 0.f;
#pragma unroll
        for (int w = 0; w < 8; ++w) { q2 = fmaxf(q2, sf[w]); k2 = fmaxf(k2, sf[8 + w]); }
        const float thr = 2.04f * sqrtf(q2 * k2) + 40.f;
        const float* C = CB + (size_t)bh * SEQ; const int tmax = P0 / KVBLK;
        const bool keep = (lane >= tmax) || (C[64 * lane + 63] - C[P0] >= -thr);
        const unsigned long long m = __ballot(keep);
        if (tid == 0) jtab[L] = __builtin_ctzll(m);
    }
}
__device__ __forceinline__ void fox_phase(char* lds, const bf16* Q, const bf16* K, const bf16* V, bf16* O, const float* CB, unsigned* ctr, const int* jtab) {
    constexpr int total = NB * NH * 16 * (FOX_DOUBLE ? 2 : 1);
    int L = dq(lds, ctr); if (L >= total) return;
    int Ln = dq(lds, ctr);
    BlockRef cur = ref(L, Q, K, V, O, CB, jtab);
    Seam S;
    fox_prime(cur, lds, S);
    for (;;) {
        const bool last = Ln >= total;
        const BlockRef nxt = last ? cur : ref(Ln, Q, K, V, O, CB, jtab);
        fox_block(cur, nxt, lds, S);
        if (last) break;
        cur = nxt; L = Ln; Ln = dq(lds, ctr);
    }
}
}
namespace swa {
using bf16 = __hip_bfloat16;
typedef short bf16x8 __attribute__((ext_vector_type(8)));
typedef short s16x4 __attribute__((ext_vector_type(4)));
typedef float f32x16 __attribute__((ext_vector_type(16)));
typedef unsigned u32x4 __attribute__((ext_vector_type(4)));
constexpr int SEQ = 4096, LDQ = 2048, LDKV = 256, QT = 32, NKT = 5, KEYS = 160, VROW = 144, VBUF = KEYS * VROW, NUNITS = 4 * 4 * (SEQ / QT);
constexpr int OFF_WS = 2 * VBUF, LDS_BYTES = OFF_WS + 8 * 32 * 4;
__device__ __forceinline__ int crow(int r, int hi) { return (r & 3) + 8 * (r >> 2) + 4 * hi; }
__device__ __forceinline__ unsigned cvtpk(float lo, float hi) { unsigned r; asm volatile("v_cvt_pk_bf16_f32 %0, %1, %2" : "=v"(r) : "v"(lo), "v"(hi)); return r; }
struct UnitRef { int b, kvh, q0; };
__device__ __forceinline__ UnitRef decode(int u) { UnitRef r; r.b = u >> 9; r.kvh = (u >> 7) & 3; r.q0 = (u & 127) * QT; return r; }

template <bool O8>
__device__ __forceinline__ void swa_phase(char* lds, const bf16* Q, const bf16* Kc, const bf16* Vc, bf16* O, const float* sinks, int blk, int nblk) {
    const int tid = threadIdx.x, wid = __builtin_amdgcn_readfirstlane(tid >> 6), lane = tid & 63, r32 = lane & 31, hi = lane >> 5;
    float* wsf = (float*)(lds + OFF_WS) + wid * 32;
    int u = blk; if (u >= NUNITS) return;
    u32x4 st0, st1, st2;
#define V_LOAD(uu) do { const UnitRef R_ = decode(uu); const bf16* vb_ = Vc + (size_t)R_.b * SEQ * LDKV + R_.kvh * 64; \
        { const int c = tid, kk = c >> 3, ch = c & 7; int pos = R_.q0 - 128 + kk; pos = pos < 0 ? 0 : pos; st0 = *(const u32x4*)(vb_ + (size_t)pos * LDKV + ch * 8); } \
        { const int c = tid + 512, kk = c >> 3, ch = c & 7; int pos = R_.q0 - 128 + kk; pos = pos < 0 ? 0 : pos; st1 = *(const u32x4*)(vb_ + (size_t)pos * LDKV + ch * 8); } \
        if (tid < 256) { const int c = tid + 1024, kk = c >> 3, ch = c & 7; int pos = R_.q0 - 128 + kk; pos = pos < 0 ? 0 : pos; st2 = *(const u32x4*)(vb_ + (size_t)pos * LDKV + ch * 8); } } while (0)
#define V_WRITE(bufp) do { { const int c = tid; *(u32x4*)((bufp) + (c >> 3) * VROW + (c & 7) * 16) = st0; } \
        { const int c = tid + 512; *(u32x4*)((bufp) + (c >> 3) * VROW + (c & 7) * 16) = st1; } \
        if (tid < 256) { const int c = tid + 1024; *(u32x4*)((bufp) + (c >> 3) * VROW + (c & 7) * 16) = st2; } } while (0)
    V_LOAD(u); V_WRITE(lds);
    __syncthreads();
    int buf = 0;
    const int grp = lane >> 4, qq = (lane & 15) >> 2, pp = lane & 3;
    const int vrd = (8 * (grp >> 1) + qq) * VROW + (16 * (grp & 1) + 4 * pp) * 2;
    for (;;) {
        const int un = u + nblk; const bool has_next = un < NUNITS;
        if (has_next) V_LOAD(un);
        const UnitRef R = decode(u);
        const int h = R.kvh * 8 + wid; const size_t rowb = (size_t)R.b * SEQ;
        const float sink2 = sinks[h] * 1.4426950408889634f;
        bf16x8 qr[4];
        { const bf16* qp = Q + (rowb + R.q0 + r32) * LDQ + h * 64 + hi * 8;
#pragma unroll
          for (int d0 = 0; d0 < 4; ++d0) qr[d0] = *(const bf16x8*)(qp + d0 * 16); }
        f32x16 p[NKT];
#pragma unroll
        for (int j = 0; j < NKT; ++j) {
            int pos = R.q0 - 128 + 32 * j + r32; pos = pos < 0 ? 0 : pos;
            const bf16* kp = Kc + (rowb + pos) * LDKV + R.kvh * 64 + hi * 8;
            bf16x8 kf[4];
#pragma unroll
            for (int d0 = 0; d0 < 4; ++d0) kf[d0] = *(const bf16x8*)(kp + d0 * 16);
            f32x16 a = {};
#pragma unroll
            for (int d0 = 0; d0 < 4; ++d0) a = __builtin_amdgcn_mfma_f32_32x32x16_bf16(kf[d0], qr[d0], a, 0, 0, 0);
            p[j] = a;
        }
        { const int lo = (r32 + 1) > (128 - R.q0) ? (r32 + 1) : (128 - R.q0); const unsigned span = (unsigned)(r32 + 128 - lo); const float NEG = -__builtin_inff();
#pragma unroll
          for (int j = 0; j < NKT; ++j)
#pragma unroll
              for (int r = 0; r < 16; ++r) { const int kk = 32 * j + (r & 3) + 8 * (r >> 2) + 4 * hi; if ((unsigned)(kk - lo) > span) p[j][r] = NEG; } }
        float mx = sink2;
#pragma unroll
        for (int j = 0; j < NKT; ++j)
#pragma unroll
            for (int r = 0; r < 16; ++r) mx = fmaxf(mx, p[j][r]);
        { auto rr = __builtin_amdgcn_permlane32_swap(__float_as_uint(mx), __float_as_uint(mx), false, false); mx = fmaxf(__uint_as_float(rr[0]), __uint_as_float(rr[1])); }
        float ps = 0.f;
#pragma unroll
        for (int j = 0; j < NKT; ++j)
#pragma unroll
            for (int r = 0; r < 16; ++r) { const float e = __builtin_amdgcn_exp2f(p[j][r] - mx); p[j][r] = e; ps += e; }
        { auto rr = __builtin_amdgcn_permlane32_swap(__float_as_uint(ps), __float_as_uint(ps), false, false); ps = __uint_as_float(rr[0]) + __uint_as_float(rr[1]); }
        const float l = ps + __builtin_amdgcn_exp2f(sink2 - mx);
        bf16x8 pa[2 * NKT];
#define PK4(P, B_, OUT) do { unsigned a0 = cvtpk(P[B_+0], P[B_+1]), a1 = cvtpk(P[B_+2], P[B_+3]);                          \
        unsigned b0 = cvtpk(P[B_+4], P[B_+5]), b1 = cvtpk(P[B_+6], P[B_+7]);                                             \
        auto r0 = __builtin_amdgcn_permlane32_swap(a0, b0, false, false); auto r1 = __builtin_amdgcn_permlane32_swap(a1, b1, false, false); \
        u32x4 w = {r0[0], r1[0], r0[1], r1[1]}; OUT = *reinterpret_cast<bf16x8*>(&w); } while (0)
#pragma unroll
        for (int j = 0; j < NKT; ++j) { PK4(p[j], 0, pa[2 * j]); PK4(p[j], 8, pa[2 * j + 1]); }
#undef PK4
        f32x16 o[2] = {};
        const int vb = (int)(uintptr_t)(lds + buf * VBUF) + vrd;
#define TRRD(dst, off) asm volatile("ds_read_b64_tr_b16 %0, %1 offset:%2" : "=&v"(dst) : "v"(vb), "i"(off) : "memory")
#pragma unroll
        for (int g = 0; g < 2 * NKT; ++g) {
            s16x4 l0, h0, l1, h1;
            TRRD(l0, g * 16 * VROW); TRRD(h0, g * 16 * VROW + 4 * VROW); TRRD(l1, g * 16 * VROW + 64); TRRD(h1, g * 16 * VROW + 4 * VROW + 64);
            asm volatile("s_waitcnt lgkmcnt(0)" ::: "memory"); __builtin_amdgcn_sched_barrier(0);
            o[0] = __builtin_amdgcn_mfma_f32_32x32x16_bf16(pa[g], (bf16x8){l0[0], l0[1], l0[2], l0[3], h0[0], h0[1], h0[2], h0[3]}, o[0], 0, 0, 0);
            o[1] = __builtin_amdgcn_mfma_f32_32x32x16_bf16(pa[g], (bf16x8){l1[0], l1[1], l1[2], l1[3], h1[0], h1[1], h1[2], h1[3]}, o[1], 0, 0, 0);
        }
#undef TRRD
        if (hi == 0) wsf[r32] = l;
        asm volatile("s_waitcnt lgkmcnt(0)" ::: "memory");
        if constexpr (O8) { unsigned char* Ow = (unsigned char*)O + (rowb + R.q0) * LDQ + h * 64;
#pragma unroll
          for (int r = 0; r < 16; ++r) { const int orow = crow(r, hi); const float rl = __builtin_amdgcn_rcpf(wsf[orow]) * 16.f;
#pragma unroll
            for (int d0 = 0; d0 < 2; ++d0) { const float v = o[d0][r] * rl; const float vn = __shfl_xor(v, 1);
                if ((r32 & 1) == 0) *(unsigned short*)(Ow + (size_t)orow * LDQ + d0 * 32 + r32) = (unsigned short)__builtin_amdgcn_cvt_pk_fp8_f32(v, vn, 0, false); } } }
        else { bf16* Ow = O + (rowb + R.q0) * LDQ + h * 64;
#pragma unroll
          for (int r = 0; r < 16; ++r) { const int orow = crow(r, hi); const float rl = __builtin_amdgcn_rcpf(wsf[orow]);
#pragma unroll
            for (int d0 = 0; d0 < 2; ++d0) { const float v = o[d0][r] * rl; const float vn = __shfl_xor(v, 1);
                if ((r32 & 1) == 0) *(unsigned*)(Ow + (size_t)orow * LDQ + d0 * 32 + r32) = cvtpk(v, vn); } } }
        if (has_next) V_WRITE(lds + (buf ^ 1) * VBUF);
        __syncthreads();
        if (!has_next) break;
        u = un; buf ^= 1;
    }
#undef V_LOAD
#undef V_WRITE
}
}
constexpr int NWAVES = 8;
#ifndef MK_PER_PHASE
#define MK_PER_PHASE 0
#endif
constexpr int N_PHASES = 18;
#ifndef FP8_MASK
#define FP8_MASK 3
#endif
constexpr float W8SCALE = 64.f;

constexpr int SEQ = 4096, NBATCH = 4, T = NBATCH * SEQ, D = 2048, NEXP = 64, TOPK = 8, EH = 512;
constexpr int NQKV_A = 3 * D, LDWIN = 3 * D + 16, NQKV_B = D + 512;
constexpr float ALPHA = 1.4142135623730951f, LN_EPS = 1e-5f;
constexpr float QSCALE_A = 0.08838834764831845f * 1.4426950408889634f;
constexpr float QSCALE_B = 0.125f * 1.4426950408889634f;
constexpr int MAXTILES = 640, MAXROWS = MAXTILES * 256;

constexpr size_t MiB = 1u << 20;
constexpr size_t WS_CTL = 0, CTL_ZERO_BYTES = 1 * MiB;
constexpr size_t WS_ROPE = 1 * MiB;
constexpr size_t WS_LOGF = 2 * MiB;
constexpr size_t WS_CB = 3 * MiB;
constexpr size_t WS_EIDX = 4 * MiB, WS_WTS = WS_EIDX + 512 * 1024, WS_SLOT = 5 * MiB, WS_TOK = WS_SLOT + 512 * 1024, WS_GATE = WS_TOK + 640 * 1024, WS_TILE = 7 * MiB;
constexpr size_t WS_NRM = 1360 * MiB;
constexpr size_t WS_GHIST = 8 * MiB;
constexpr size_t WS_GT = 9 * MiB;
constexpr size_t WS_WQKV_A = 12 * MiB, WS_WO_A = 36 * MiB, WS_WQKV_B = 44 * MiB, WS_WO_B = 54 * MiB;
constexpr size_t WS_WGU = 64 * MiB, WGU_L = 260 * MiB, WS_WD = 584 * MiB, WD_L = 130 * MiB;
constexpr size_t WS_XB = 848 * MiB, WS_QB = 912 * MiB, WS_KB = 976 * MiB, WS_VB = 1040 * MiB, WS_AO = 1104 * MiB;
constexpr size_t WS_Y1 = 1168 * MiB, WS_X1 = 1296 * MiB, WS_X1B = 1424 * MiB, WS_ACT = 1488 * MiB, WS_YP = 1648 * MiB, WS_X2 = 2288 * MiB, WS_END = 2416 * MiB;
static_assert(WS_GT + 2 * 64 * 2048 * 4 + 4096 <= WS_WQKV_A && WS_ACT + (size_t)MAXROWS * 512 * 2 <= WS_YP && WS_YP + (size_t)MAXROWS * 2048 * 2 <= WS_X2, "ws map");
constexpr int CW_TMO = 0;
constexpr int CW_CNT = 1024;
constexpr int CW_CUR = 2048;
constexpr int CW_CVTQ = 3648;
constexpr int CW_FOXQ = 3584;
constexpr int CW_NT = 3072;
constexpr int CW_BAR = 4096;

constexpr int RING_OFF = 0, RING_BYTES = 131072;
constexpr int LDSCTL_OFF = RING_BYTES, MISC_OFF = LDSCTL_OFF + 320;
constexpr int LDS_BYTES = 147456;
static_assert(MISC_OFF + 128 <= LDS_BYTES && fox::LDS_BYTES + 256 <= RING_BYTES && swa::LDS_BYTES <= RING_BYTES, "LDS map");

#define GAS __attribute__((address_space(1)))
#define LAS __attribute__((address_space(3)))
typedef unsigned short bf16;
typedef unsigned v4u __attribute__((ext_vector_type(4)));
typedef unsigned v2u __attribute__((ext_vector_type(2)));
typedef float f32x4 __attribute__((ext_vector_type(4)));
typedef GAS unsigned gu32;
#define RLX_AGENT __ATOMIC_RELAXED, __HIP_MEMORY_SCOPE_AGENT
#define LDS_WAIT() asm volatile("s_waitcnt lgkmcnt(0)" ::: "memory")
#define VM_WAIT() asm volatile("s_waitcnt vmcnt(0)" ::: "memory")
__device__ __forceinline__ unsigned f2bf(float f) { unsigned u = __builtin_bit_cast(unsigned, f); return (u + 0x7fffu + ((u >> 16) & 1u)) >> 16; }
__device__ __forceinline__ unsigned pk2(float lo, float hi) { return f2bf(lo) | (f2bf(hi) << 16); }
__device__ __forceinline__ float bf_lo(unsigned w) { return __builtin_bit_cast(float, w << 16); }
__device__ __forceinline__ float bf_hi(unsigned w) { return __builtin_bit_cast(float, w & 0xffff0000u); }

#define XB_TMO      128
#define XB_XCNT(j)  (256  + 64 * (j))
#define XB_XSUB(j)  (1280 + 64 * (j))
#define XB_XGEN(j)  (2304 + 64 * (j))
#define XB_TOP      3328
#define XB_TOPGEN   3392
#define XCD_BAR_WORDS 3456
#define XB_SPIN_CAP (1u << 18)

__device__ __forceinline__ unsigned xb_ld(unsigned* p)              { return __hip_atomic_load(p, __ATOMIC_RELAXED, __HIP_MEMORY_SCOPE_AGENT); }
__device__ __forceinline__ unsigned xb_add(unsigned* p, unsigned v) { return __hip_atomic_fetch_add(p, v, __ATOMIC_RELAXED, __HIP_MEMORY_SCOPE_AGENT); }
__device__ __forceinline__ unsigned xb_xcc_id() { return (unsigned)__builtin_amdgcn_s_getreg((3 << 11) | 20) & 0xFu; }
#define XB_SPIN(cond, bar) do { unsigned _sp = 0; while (cond) { __builtin_amdgcn_s_sleep(1); \
    if ((++_sp & 255u) == 0u) { if (xb_ld(&(bar)[XB_TMO])) break; if (_sp > XB_SPIN_CAP) { atomicAdd(&(bar)[XB_TMO], 1u); break; } } } } while (0)

struct XcdBarrier {
    unsigned* bar; unsigned x;
    volatile LAS unsigned* st;
};
__device__ __forceinline__ XcdBarrier xcd_barrier_post(unsigned* bar, volatile LAS unsigned* st) {
    XcdBarrier b; b.bar = bar; b.x = xb_xcc_id(); b.st = st;
    if (threadIdx.x == 0) (void)xb_add(&bar[XB_XCNT(b.x)], 1u);
    return b;
}
__device__ __forceinline__ void xcd_barrier_complete(unsigned* bar, unsigned x, unsigned& nloc, unsigned& nx) {
    const unsigned G = gridDim.x * gridDim.y * gridDim.z;
    unsigned sum, cnt, mine, sp = 0u;
    for (;;) {
        sum = 0u; cnt = 0u; mine = 0u;
#pragma unroll
        for (unsigned j = 0; j < 16; ++j) { const unsigned c = xb_ld(&bar[XB_XCNT(j)]); sum += c; cnt += (c > 0u) ? 1u : 0u; mine = (j == x) ? c : mine; }
        if (sum == G) break;
        __builtin_amdgcn_s_sleep(1);
        if ((++sp & 255u) == 0u) { if (xb_ld(&bar[XB_TMO])) break; if (sp > XB_SPIN_CAP) { atomicAdd(&bar[XB_TMO], 1u); break; } }
    }
    nloc = mine > 0u ? mine : 1u; nx = cnt > 0u ? cnt : 1u;
}
__device__ __forceinline__ void xcd_barrier(const XcdBarrier& b) {
    asm volatile("s_waitcnt vmcnt(0)" ::: "memory");
    __syncthreads();
    if (threadIdx.x == 0) {
        unsigned* bar = b.bar;
        __builtin_amdgcn_s_waitcnt(0);
        unsigned nloc = b.st[0], nx = b.st[1];
        if (nloc == 0u) { xcd_barrier_complete(bar, b.x, nloc, nx); b.st[0] = nloc; b.st[1] = nx; }
        const unsigned old = xb_add(&bar[XB_XSUB(b.x)], 1u);
        const unsigned gen = old / nloc;
        if (old + 1u == (gen + 1u) * nloc) {
            __builtin_amdgcn_fence(__ATOMIC_RELEASE, "agent");
            asm volatile("s_waitcnt vmcnt(0)" ::: "memory");
            const unsigned og = xb_add(&bar[XB_TOP], 1u);
            const unsigned tg = og / nx;
            if (og + 1u == (tg + 1u) * nx) xb_add(&bar[XB_TOPGEN], 1u);
            else XB_SPIN(xb_ld(&bar[XB_TOPGEN]) == tg, bar);
            __builtin_amdgcn_fence(__ATOMIC_ACQUIRE, "agent");
            xb_add(&bar[XB_XGEN(b.x)], 1u);
            asm volatile("s_waitcnt vmcnt(0)" ::: "memory");
        } else {
            XB_SPIN(xb_ld(&bar[XB_XGEN(b.x)]) == gen, bar);
            __builtin_amdgcn_fence(__ATOMIC_ACQUIRE, "agent");
            asm volatile("s_waitcnt vmcnt(0)" ::: "memory");
        }
    }
    __syncthreads();
}

struct Frame {
    LAS unsigned char* lds;
    unsigned char* ws;
    gu32* ctl;
    int tid, lane, wave;
    int vcu, G;
    const float* in[18]; float* out;
};
__device__ __forceinline__ float wave_sum(float v) {
#pragma unroll
    for (int o = 1; o < 64; o <<= 1) v += __shfl_xor(v, o);
    return v;
}

__device__ __forceinline__ int map_rope(int n) { const int t = n >> 8, w = n & 127, bj = (n >> 7) & 1; return 256 * t + 64 * (w >> 5) + 32 * bj + (w & 31); }
__device__ __forceinline__ int map_gu(int n) { const int t = n >> 8, w = n & 127, bj = (n >> 7) & 1; return 512 * bj + 128 * t + w; }

constexpr int CVT_I_QKVA = 16 * (NQKV_A / 32), CVT_I_WO = 16 * (D / 32), CVT_I_QKVB = 16 * (NQKV_B / 32), CVT_I_GU1 = 16 * 32, CVT_I_D1 = 4 * 64;
constexpr int CVT_O_WOA = CVT_I_QKVA, CVT_O_QKVB = CVT_O_WOA + CVT_I_WO, CVT_O_WOB = CVT_O_QKVB + CVT_I_QKVB, CVT_O_GU = CVT_O_WOB + CVT_I_WO, CVT_O_D = CVT_O_GU + 2 * 65 * CVT_I_GU1, CVT_NSUPER = CVT_O_D + 2 * 65 * CVT_I_D1;
constexpr int CVT_CH = 16, CVT_NCHUNK = (CVT_NSUPER - CVT_O_GU) / CVT_CH;
static_assert((CVT_NSUPER - CVT_O_GU) % CVT_CH == 0, "chunking");
template <bool DYN>
__device__ __forceinline__ void convert_weights(Frame& F, LAS float* scr, int limit = CVT_NCHUNK) {
    const int gw = F.vcu * NWAVES + F.wave, NGW = F.G * NWAVES, lane = F.lane;
    unsigned char* ws = F.ws;
    constexpr int O_WOA = CVT_O_WOA, O_QKVB = CVT_O_QKVB, O_WOB = CVT_O_WOB, O_GU = CVT_O_GU, O_D = CVT_O_D, I_GU1 = CVT_I_GU1, I_D1 = CVT_I_D1;
    constexpr int END = 0x7fffffff;
    struct TrD { const float* W; unsigned char* WT; int ldw, Kb, f8; };
    auto decode = [&](int step) -> TrD { TrD d; const int it = step >> 1, hf = step & 1;
        if (it < O_WOA) { const int nb = it % (NQKV_A / 32), kb = 2 * (it / (NQKV_A / 32)) + hf; d.W = F.in[1] + (size_t)(64 * kb) * LDWIN + 32 * nb; d.ldw = LDWIN; d.f8 = (ATT8_MASK >> 3) & 1; d.Kb = d.f8 ? D : D * 2; d.WT = ws + WS_WQKV_A + (size_t)(32 * nb) * d.Kb + (d.f8 ? 64 : 128) * kb; }
        else if (it < O_QKVB) { const int r = it - O_WOA, nb = r % 64, kb = 2 * (r / 64) + hf; d.W = F.in[3] + (size_t)(64 * kb) * D + 32 * nb; d.ldw = D; d.f8 = (ATT8_MASK >> 2) & 1; d.Kb = d.f8 ? D : D * 2; d.WT = ws + WS_WO_A + (size_t)(32 * nb) * d.Kb + (d.f8 ? 64 : 128) * kb; }
        else if (it < O_WOB) { const int r = it - O_QKVB, nb = r % (NQKV_B / 32), kb = 2 * (r / (NQKV_B / 32)) + hf, n = 32 * nb; d.f8 = (ATT8_MASK >> 1) & 1; d.Kb = d.f8 ? D : D * 2; d.WT = ws + WS_WQKV_B + (size_t)n * d.Kb + (d.f8 ? 64 : 128) * kb;
            if (n < D) { d.W = F.in[5] + (size_t)(64 * kb) * D + map_rope(n); d.ldw = D; }
            else if (n < D + 256) { d.W = F.in[4] + (size_t)(64 * kb) * 512 + map_rope(n - D); d.ldw = 512; }
            else { d.W = F.in[4] + (size_t)(64 * kb) * 512 + (n - D); d.ldw = 512; } }
        else if (it < O_GU) { const int r = it - O_WOB, nb = r % 64, kb = 2 * (r / 64) + hf; d.W = F.in[7] + (size_t)(64 * kb) * D + 32 * nb; d.ldw = D; d.f8 = ATT8_MASK & 1; d.Kb = d.f8 ? D : D * 2; d.WT = ws + WS_WO_B + (size_t)(32 * nb) * d.Kb + (d.f8 ? 64 : 128) * kb; }
        else if (it < O_D) { const int r = it - O_GU, le = r / I_GU1, q = r % I_GU1, l = le / 65, e = le % 65, nb = q % 32, kb = 2 * (q / 32) + hf;
            const float* src = e < 64 ? F.in[10] + ((size_t)(l * 64 + e)) * D * 1024 : F.in[12] + (size_t)l * D * 1024;
            d.W = src + (size_t)(64 * kb) * 1024 + map_gu(32 * nb); d.ldw = 1024; d.f8 = (FP8_MASK >> l) & 1; d.Kb = d.f8 ? D : D * 2;
            d.WT = ws + WS_WGU + (size_t)l * WGU_L + ((size_t)e * 1024 + 32 * nb) * d.Kb + (d.f8 ? 64 : 128) * kb; }
        else { const int r = it - O_D, le = r / I_D1, q = r % I_D1, l = le / 65, e = le % 65, nb = q % 64, kb = 2 * (q / 64) + hf;
            const float* src = e < 64 ? F.in[11] + ((size_t)(l * 64 + e)) * EH * D : F.in[13] + (size_t)l * EH * D;
            d.W = src + (size_t)(64 * kb) * D + 32 * nb; d.ldw = D; d.f8 = (FP8_MASK >> l) & 1; d.Kb = d.f8 ? EH : EH * 2;
            d.WT = ws + WS_WD + (size_t)l * WD_L + ((size_t)e * D + 32 * nb) * d.Kb + (d.f8 ? 64 : 128) * kb; }
        return d; };
    gu32* cq = F.ctl + CW_CVTQ;
    auto pull = [&]() -> int { unsigned v = 0u; if (lane == 0) v = __hip_atomic_fetch_add(cq, 1u, RLX_AGENT); return __builtin_amdgcn_readfirstlane((int)v); };
    int chunk_end = 0, nextchunk = 0; bool no_more = false;
    int it;
    if constexpr (DYN) { const int c0 = pull(); no_more = c0 >= limit; nextchunk = no_more ? CVT_NCHUNK : pull(); no_more = no_more || nextchunk >= limit;
        if (c0 >= CVT_NCHUNK) it = END; else { it = 2 * (O_GU + c0 * CVT_CH); chunk_end = O_GU + (c0 + 1) * CVT_CH; } }
    else it = gw < O_GU ? 2 * gw : END;
    auto advance = [&](int cur) -> int {
        if (cur == END) return END;
        if (!(cur & 1)) return cur + 1;
        if constexpr (DYN) { const int s = (cur >> 1) + 1; if (s < chunk_end) return 2 * s;
            const int c = nextchunk; if (c >= CVT_NCHUNK) return END; nextchunk = no_more ? CVT_NCHUNK : pull(); no_more = no_more || nextchunk >= limit; chunk_end = O_GU + (c + 1) * CVT_CH; return 2 * (O_GU + c * CVT_CH); }
        else { const int s = (cur >> 1) + NGW; return s < O_GU ? 2 * s : END; } };
    const int r8 = lane >> 3, c4 = (lane & 7) * 4;
    auto load = [&](f32x4 (&v)[8], const TrD& d) {
#pragma unroll
        for (int i = 0; i < 8; ++i) v[i] = __builtin_nontemporal_load((const GAS f32x4*)(d.W + (size_t)(8 * i + r8) * d.ldw + c4)); };
    auto process = [&](const f32x4 (&v)[8], const TrD& d) {
#pragma unroll
        for (int i = 0; i < 8; ++i) { LAS float* p = scr + (8 * i + r8) * 33 + c4; p[0] = v[i].x; p[1] = v[i].y; p[2] = v[i].z; p[3] = v[i].w; }
        LDS_WAIT(); asm volatile("" ::: "memory");
        if (d.f8) { const int c = lane & 3;
#pragma unroll
            for (int h = 0; h < 2; ++h) { const int n = (lane >> 2) + 16 * h; const LAS float* s = scr + (16 * c) * 33 + n;
                v4u o;
                o.x = pg8::pk4_fp8(s[0 * 33] * W8SCALE, s[1 * 33] * W8SCALE, s[2 * 33] * W8SCALE, s[3 * 33] * W8SCALE);
                o.y = pg8::pk4_fp8(s[4 * 33] * W8SCALE, s[5 * 33] * W8SCALE, s[6 * 33] * W8SCALE, s[7 * 33] * W8SCALE);
                o.z = pg8::pk4_fp8(s[8 * 33] * W8SCALE, s[9 * 33] * W8SCALE, s[10 * 33] * W8SCALE, s[11 * 33] * W8SCALE);
                o.w = pg8::pk4_fp8(s[12 * 33] * W8SCALE, s[13 * 33] * W8SCALE, s[14 * 33] * W8SCALE, s[15 * 33] * W8SCALE);
                __builtin_nontemporal_store(o, (GAS v4u*)(d.WT + (size_t)n * d.Kb + 16 * c)); } }
        else { const int c = lane & 7;
#pragma unroll
            for (int j = 0; j < 4; ++j) { const int n = (lane >> 3) + 8 * j; const LAS float* s = scr + (8 * c) * 33 + n;
                v4u o; o.x = pk2(s[0 * 33], s[1 * 33]); o.y = pk2(s[2 * 33], s[3 * 33]); o.z = pk2(s[4 * 33], s[5 * 33]); o.w = pk2(s[6 * 33], s[7 * 33]);
                *(GAS v4u*)(d.WT + (size_t)n * d.Kb + 16 * c) = o; } }
        LDS_WAIT(); asm volatile("" ::: "memory"); };
    f32x4 v0[8], v1[8], v2[8]; TrD d0{}, d1{}, d2{};
    int it0 = it, it1 = advance(it0), it2 = advance(it1);
    if (it0 != END) { d0 = decode(it0); load(v0, d0); }
    if (it1 != END) { d1 = decode(it1); load(v1, d1); }
    if (it2 != END) { d2 = decode(it2); load(v2, d2); }
    for (;;) {
        if (it0 == END) break;
        process(v0, d0); it0 = advance(it2); if (it0 != END) { d0 = decode(it0); load(v0, d0); }
        if (it1 == END) break;
        process(v1, d1); it1 = advance(it0); if (it1 != END) { d1 = decode(it1); load(v1, d1); }
        if (it2 == END) break;
        process(v2, d2); it2 = advance(it1); if (it2 != END) { d2 = decode(it2); load(v2, d2); }
    }
}

__device__ __forceinline__ void p0_prologue(Frame& F) {
    LAS float* scr = (LAS float*)(F.lds + RING_OFF + F.wave * 16384);
    const int gw = F.vcu * NWAVES + F.wave, NGW = F.G * NWAVES, lane = F.lane;
    unsigned char* ws = F.ws;
    {
        const float* x = F.in[0]; const float* win = F.in[1]; const float* bfv = F.in[2];
        bf16* xb = (bf16*)(ws + WS_XB); float* logf = (float*)(ws + WS_LOGF);
        const int r = lane & 15, kq = lane >> 4;
        for (int base = F.vcu * 4; base < T / 16; base += F.G * 4) {
            const int grp = base + (F.wave >> 1), kh = F.wave & 1;
            const float* xr = x + (size_t)(grp * 16 + r) * D + 4 * kq + kh * (D / 2); bf16* xo = xb + (size_t)(grp * 16 + r) * D + 4 * kq + kh * (D / 2); unsigned char* x8 = ws + WS_X1 + (size_t)(grp * 16 + r) * D + 4 * kq + kh * (D / 2);
            const float* wf = win + NQKV_A + r + (size_t)(4 * kq + kh * (D / 2)) * LDWIN;
            f32x4 acc = {0.f, 0.f, 0.f, 0.f};
#pragma unroll 8
            for (int j = 0; j < D / 32; ++j) {
                const f32x4 xv = *(const f32x4*)(xr + 16 * j);
                const float* wp = wf + (size_t)(16 * j) * LDWIN;
                const float w0 = wp[0], w1 = wp[LDWIN], w2 = wp[2 * LDWIN], w3 = wp[3 * LDWIN];
                acc = __builtin_amdgcn_mfma_f32_16x16x4f32(xv[0], w0, acc, 0, 0, 0);
                acc = __builtin_amdgcn_mfma_f32_16x16x4f32(xv[1], w1, acc, 0, 0, 0);
                acc = __builtin_amdgcn_mfma_f32_16x16x4f32(xv[2], w2, acc, 0, 0, 0);
                acc = __builtin_amdgcn_mfma_f32_16x16x4f32(xv[3], w3, acc, 0, 0, 0);
                if constexpr ((ATT8_MASK & 8) != 0) *(GAS unsigned*)(x8 + 16 * j) = pg8::pk4_fp8(xv[0], xv[1], xv[2], xv[3]);
                else { v2u o; o.x = pk2(xv[0], xv[1]); o.y = pk2(xv[2], xv[3]); *(GAS v2u*)(xo + 16 * j) = o; }
            }
            LAS f32x4* ex = (LAS f32x4*)(F.lds + RING_OFF) + (F.wave >> 1) * 64 + lane;
            if (kh) *ex = acc;
            __syncthreads();
            if (!kh) { acc += *ex;
                const float bb = bfv[r];
#pragma unroll
                for (int i = 0; i < 4; ++i) { const float z = acc[i] + bb; const float ls = -(fmaxf(-z, 0.f) + log1pf(expf(-fabsf(z))));
                    logf[(size_t)(grp * 16 + 4 * kq + i) * 16 + r] = ls; } }
            __syncthreads();
        }
    }
    {
        { float* nz = (float*)(ws + WS_NRM); for (int i = gw * 64 + lane; i < 2 * 64 * SEQ; i += NGW * 64) nz[i] = 0.f; }
        float* cs = (float*)(ws + WS_ROPE); float* sn = cs + SEQ * 32;
        const int gt = gw * 64 + lane, NGT = NGW * 64;
        for (int i = gt; i < SEQ * 32; i += NGT) { const int pos = i >> 5, d = i & 31;
            const double inv = exp(-(double)d * (9.210340371976184 / 32.0)); const double ang = (double)pos * inv;
            cs[i] = (float)cos(ang); sn[i] = (float)sin(ang); }
        float* GT = (float*)(ws + WS_GT); float* c1 = GT + 2 * 64 * 2048; float* c0 = c1 + 128;
        for (int it = gw; it < 128; it += NGW) { const int l = it >> 6, e = it & 63;
            const float* rw = F.in[8] + (size_t)l * D * 64 + e; const float* g = F.in[14] + l * D; const float* b = F.in[15] + l * D;
            float s1 = 0.f, s0 = 0.f;
            for (int k0 = lane; k0 < D; k0 += 64 * 8) { float w8[8], g8[8], b8[8];
#pragma unroll
                for (int u = 0; u < 8; ++u) { const int k = k0 + 64 * u; w8[u] = rw[(size_t)k * 64]; g8[u] = g[k]; b8[u] = b[k]; }
#pragma unroll
                for (int u = 0; u < 8; ++u) { const int k = k0 + 64 * u; const float gv = g8[u] * w8[u]; GT[(size_t)it * D + k] = gv; s1 += gv; s0 += b8[u] * w8[u]; } }
            s1 = wave_sum(s1); s0 = wave_sum(s0);
            if (lane == 0) { c1[it] = s1; c0[it] = s0; } }
    }
    convert_weights<false>(F, scr);
}

__device__ __forceinline__ void p1_scan(Frame& F) {
    LAS double* sh = (LAS double*)(F.lds + RING_OFF);
    const float* logf = (const float*)(F.ws + WS_LOGF); float* cb = (float*)(F.ws + WS_CB);
    for (int ch = (F.G == 256) ? (int)blockIdx.x - 192 : (int)blockIdx.x; ch >= 0 && ch < 64; ch += F.G) {
        const int b = ch >> 4, h = ch & 15; const int s0 = F.tid * 8;
        double v[8]; double run = 0.0;
#pragma unroll
        for (int i = 0; i < 8; ++i) { run += (double)logf[((size_t)b * SEQ + s0 + i) * 16 + h]; v[i] = run; }
        double inc = run;
#pragma unroll
        for (int o = 1; o < 64; o <<= 1) { const double n = __shfl_up(inc, o); if (F.lane >= o) inc += n; }
        if (F.lane == 63) sh[F.wave] = inc;
        __syncthreads();
        double base = 0.0;
        for (int w = 0; w < F.wave; ++w) base += sh[w];
        base += inc - run;
#pragma unroll
        for (int i = 0; i < 8; ++i) cb[(size_t)ch * SEQ + s0 + i] = (float)(-(base + v[i]) * 1.4426950408889634);
        __syncthreads();
    }
}

template <bool XF32>
__device__ __forceinline__ void ln_router_phase(Frame& F, int l, const void* xres, const bf16* hmix, bf16* x1b, unsigned char* x1q) {
    const int lane = F.lane;
    auto ldy = [&](size_t elem) -> f32x4 {
        const v2u hw_ = *(const GAS v2u*)(hmix + elem); f32x4 xv;
        if constexpr (XF32) xv = *(const GAS f32x4*)((const float*)xres + elem);
        else { const v2u xw = *(const GAS v2u*)((const bf16*)xres + elem); xv = (f32x4){bf_lo(xw.x), bf_hi(xw.x), bf_lo(xw.y), bf_hi(xw.y)}; }
        return xv * ALPHA + (f32x4){bf_lo(hw_.x), bf_hi(hw_.x), bf_lo(hw_.y), bf_hi(hw_.y)}; };
    LAS float* wsc = (LAS float*)(F.lds + RING_OFF + F.wave * 8704);
    LAS float* sc = wsc; LAS float* chs = wsc + 16 * 65; LAS unsigned* hw = (LAS unsigned*)(wsc + 2 * 16 * 65);
    LAS float* smean = (LAS float*)(F.lds + RING_OFF + 8 * 8704); LAS float* srstd = smean + 64;
    const float* g = F.in[14] + l * D; const float* bta = F.in[15] + l * D;
    const float* GT = (const float*)(F.ws + WS_GT) + (size_t)l * 64 * D; const float* c1 = (const float*)(F.ws + WS_GT) + 2 * 64 * D + l * 64; const float* c0 = c1 + 128;
    const float* rbias = F.in[9] + l * 64;
    int* eidx = (int*)(F.ws + WS_EIDX); float* wts = (float*)(F.ws + WS_WTS); unsigned* ghist = (unsigned*)(F.ws + WS_GHIST);
    LAS f32x4* gl = (LAS f32x4*)(F.lds + RING_OFF + 98304); LAS f32x4* bl = gl + D / 4;
    gl[F.tid] = ((const GAS f32x4*)g)[F.tid]; bl[F.tid] = ((const GAS f32x4*)bta)[F.tid];
    __syncthreads();
    for (int chunk = F.vcu; chunk < T / 64; chunk += F.G) {
        for (int rr = 0; rr < 8; rr += 2) {
            const int lr = F.wave * 8 + rr; const size_t row = (size_t)chunk * 64 + lr;
            f32x4 v[2][8]; float s[2] = {0.f, 0.f};
#pragma unroll
            for (int q = 0; q < 2; ++q)
#pragma unroll
                for (int j = 0; j < 8; ++j) v[q][j] = ldy((row + q) * D + 4 * lane + 256 * j);
#pragma unroll
            for (int q = 0; q < 2; ++q)
#pragma unroll
                for (int j = 0; j < 8; ++j) s[q] += (v[q][j].x + v[q][j].y) + (v[q][j].z + v[q][j].w);
            float mean[2], rstd[2], s2[2] = {0.f, 0.f};
#pragma unroll
            for (int o = 1; o < 64; o <<= 1) { s[0] += __shfl_xor(s[0], o); s[1] += __shfl_xor(s[1], o); }
#pragma unroll
            for (int q = 0; q < 2; ++q) { mean[q] = s[q] * (1.f / D);
#pragma unroll
                for (int j = 0; j < 8; ++j) { v[q][j] = v[q][j] - mean[q]; s2[q] += (v[q][j].x * v[q][j].x + v[q][j].y * v[q][j].y) + (v[q][j].z * v[q][j].z + v[q][j].w * v[q][j].w); } }
#pragma unroll
            for (int o = 1; o < 64; o <<= 1) { s2[0] += __shfl_xor(s2[0], o); s2[1] += __shfl_xor(s2[1], o); }
#pragma unroll
            for (int q = 0; q < 2; ++q) { rstd[q] = 1.f / sqrtf(s2[q] * (1.f / D) + LN_EPS); if (lane == 0) { smean[lr + q] = mean[q]; srstd[lr + q] = rstd[q]; } }
#pragma unroll
            for (int j = 0; j < 8; ++j) { const f32x4 gv = gl[lane + 64 * j], bv = bl[lane + 64 * j];
#pragma unroll
                for (int q = 0; q < 2; ++q) { const f32x4 o = v[q][j] * rstd[q] * gv + bv; v2u w; w.x = pk2(o.x, o.y); w.y = pk2(o.z, o.w);
                    ((GAS v2u*)(x1b + (row + q) * D) + lane)[64 * j] = w;
                    if (x1q) ((GAS unsigned*)(x1q + (row + q) * D) + lane)[64 * j] = pg8::pk4_fp8(o.x, o.y, o.z, o.w); } }
        }
        LDS_WAIT();
        __syncthreads();
        {
            const int grp = chunk * 4 + (F.wave & 3), kh = F.wave >> 2;
            const int r = lane & 15, kq = lane >> 4;
            const size_t yo = ((size_t)grp * 16 + r) * D + 4 * kq + kh * (D / 2); const float* gt = GT + (size_t)r * D + 4 * kq + kh * (D / 2);
            f32x4 acc[4];
#pragma unroll
            for (int nt = 0; nt < 4; ++nt) acc[nt] = (f32x4){0.f, 0.f, 0.f, 0.f};
#pragma unroll 4
            for (int j = 0; j < D / 32; ++j) {
                const f32x4 yv = ldy(yo + 16 * j);
#pragma unroll
                for (int nt = 0; nt < 4; ++nt) { const f32x4 wv = *(const f32x4*)(gt + (size_t)(16 * nt) * D + 16 * j);
                    acc[nt] = __builtin_amdgcn_mfma_f32_16x16x4f32(yv[0], wv[0], acc[nt], 0, 0, 0);
                    acc[nt] = __builtin_amdgcn_mfma_f32_16x16x4f32(yv[1], wv[1], acc[nt], 0, 0, 0);
                    acc[nt] = __builtin_amdgcn_mfma_f32_16x16x4f32(yv[2], wv[2], acc[nt], 0, 0, 0);
                    acc[nt] = __builtin_amdgcn_mfma_f32_16x16x4f32(yv[3], wv[3], acc[nt], 0, 0, 0); }
            }
            LAS f32x4* px = (LAS f32x4*)(F.lds + RING_OFF + 8 * 8704 + 1024) + (F.wave & 3) * 256;
            if (kh) {
#pragma unroll
                for (int nt = 0; nt < 4; ++nt) px[nt * 64 + lane] = acc[nt]; }
            LDS_WAIT();
            __syncthreads();
            if (!kh) {
#pragma unroll
            for (int nt = 0; nt < 4; ++nt) acc[nt] = acc[nt] + px[nt * 64 + lane];
            hw[lane] = 0u;
#pragma unroll
            for (int nt = 0; nt < 4; ++nt) { const int e = 16 * nt + r; const float cc1 = c1[e], cc0 = c0[e], rb = rbias[e];
#pragma unroll
                for (int i = 0; i < 4; ++i) { const int rw_ = 4 * kq + i; const float lg = srstd[F.wave * 16 + rw_] * (acc[nt][i] - smean[F.wave * 16 + rw_] * cc1) + cc0;
                    const float s = 1.f / (1.f + expf(-lg)); sc[rw_ * 65 + e] = s; chs[rw_ * 65 + e] = s + rb; } }
            LDS_WAIT(); asm volatile("" ::: "memory");
            if (lane < 16) {
                const LAS float* ch = chs + lane * 65; const LAS float* so = sc + lane * 65;
                float gs[8];
#pragma unroll
                for (int gi = 0; gi < 8; ++gi) { float m1 = -__builtin_inff(), m2 = -__builtin_inff();
#pragma unroll
                    for (int i = 0; i < 8; ++i) { const float v = ch[gi * 8 + i]; if (v > m1) { m2 = m1; m1 = v; } else if (v > m2) m2 = v; }
                    gs[gi] = m1 + m2; }
                unsigned gmask = 0u;
#pragma unroll
                for (int gi = 0; gi < 8; ++gi) { int cnt = 0;
#pragma unroll
                    for (int gj = 0; gj < 8; ++gj) cnt += (gs[gj] > gs[gi] || (gs[gj] == gs[gi] && gj < gi)) ? 1 : 0;
                    if (cnt < 4) gmask |= 1u << gi; }
                unsigned long long chosen = 0ull; int ei[8]; float ew[8]; float wsum = 0.f;
#pragma unroll
                for (int k = 0; k < 8; ++k) { float best = -__builtin_inff(); int bi = 0;
                    for (int e = 0; e < 64; ++e) { const bool ok = ((gmask >> (e >> 3)) & 1u) && !((chosen >> e) & 1ull); const float v = ch[e]; if (ok && v > best) { best = v; bi = e; } }
                    chosen |= 1ull << bi; ei[k] = bi; ew[k] = so[bi]; wsum += ew[k]; }
                const size_t row = (size_t)grp * 16 + lane; const float sc_ = 2.5f / wsum;
#pragma unroll
                for (int k = 0; k < 8; ++k) { eidx[row * 8 + k] = ei[k]; wts[row * 8 + k] = ew[k] * sc_; atomicAdd((unsigned*)&hw[ei[k]], 1u); }
            }
            LDS_WAIT(); asm volatile("" ::: "memory");
            ghist[(size_t)grp * 64 + lane] = hw[lane];
            }
        }
        __syncthreads();
    }
}

__device__ __forceinline__ void dispatch_phase(Frame& F, int l) {
    LAS int* cnt = (LAS int*)(F.lds + RING_OFF); LAS int* rstart = cnt + 64; LAS int* tstart = rstart + 64; LAS int* lntr = tstart + 64;
    LAS int* part_tot = lntr + 64; LAS int* part_bef = part_tot + 512; LAS int* gbase = part_bef + 512; LAS int* lh = gbase + 256;
    const int* eidx = (const int*)(F.ws + WS_EIDX); const float* wts = (const float*)(F.ws + WS_WTS); const unsigned* ghist = (const unsigned*)(F.ws + WS_GHIST);
    int* slot = (int*)(F.ws + WS_SLOT); int* tok = (int*)(F.ws + WS_TOK); float* gate = (float*)(F.ws + WS_GATE); int* tile_e = (int*)(F.ws + WS_TILE);
    const int NG = T / 16;
    for (int chunk = blockIdx.x; chunk < T / 64; chunk += F.G) {
        { const int e = F.tid & 63, part = F.tid >> 6; int tot = 0, bef = 0; const int g0 = part * (NG / 8), gfirst = chunk * 4;
          for (int gq = g0; gq < g0 + NG / 8; gq += 16) { int vv[16];
#pragma unroll
              for (int u = 0; u < 16; ++u) vv[u] = (int)ghist[(size_t)(gq + u) * 64 + e];
#pragma unroll
              for (int u = 0; u < 16; ++u) { tot += vv[u]; bef += (gq + u < gfirst) ? vv[u] : 0; } }
          part_tot[part * 64 + e] = tot; part_bef[part * 64 + e] = bef; }
        if (F.tid < 256) lh[F.tid] = 0;
        __syncthreads();
        if (F.tid < 64) { int tot = 0, bef = 0;
#pragma unroll
            for (int p = 0; p < 8; ++p) { tot += part_tot[p * 64 + F.tid]; bef += part_bef[p * 64 + F.tid]; }
            cnt[F.tid] = tot; int run = bef;
#pragma unroll
            for (int gl = 0; gl < 4; ++gl) { gbase[gl * 64 + F.tid] = run; run += (int)ghist[(size_t)(chunk * 4 + gl) * 64 + F.tid]; } }
        __syncthreads();
        if (F.tid == 0) { int ts = 0; for (int e = 0; e < 64; ++e) { tstart[e] = ts; rstart[e] = ts * 256; ts += (cnt[e] + 255) >> 8; } lntr[0] = ts; }
        __syncthreads();
        const int a = chunk * 512 + F.tid; const int e = eidx[a]; const int gl = F.tid >> 7;
        const int lr = atomicAdd((int*)&lh[gl * 64 + e], 1);
        const int dest = rstart[e] + gbase[gl * 64 + e] + lr;
        tok[dest] = a >> 3; gate[dest] = wts[a]; slot[a] = dest;
        __syncthreads();
    }
    if (blockIdx.x >= T / 64) {
        { const int e = F.tid & 63, part = F.tid >> 6; int tot = 0; const int g0 = part * (NG / 8);
          for (int gq = g0; gq < g0 + NG / 8; ++gq) tot += (int)ghist[(size_t)gq * 64 + e];
          part_tot[part * 64 + e] = tot; }
        __syncthreads();
        if (F.tid < 64) { int tot = 0;
#pragma unroll
            for (int p = 0; p < 8; ++p) tot += part_tot[p * 64 + F.tid];
            cnt[F.tid] = tot; }
        __syncthreads();
        if (F.tid == 0) { int ts = 0; for (int e = 0; e < 64; ++e) { tstart[e] = ts; rstart[e] = ts * 256; ts += (cnt[e] + 255) >> 8; } lntr[0] = ts; }
        __syncthreads();
    }
    const int ntr = lntr[0], rpad = ntr * 256;
    if (blockIdx.x == 0 && F.tid == 0) { __hip_atomic_store(F.ctl + CW_NT + l, (unsigned)(ntr + 64), RLX_AGENT); __hip_atomic_store(F.ctl + CW_NT + 2 + l, (unsigned)rpad, RLX_AGENT); }
    for (int e = blockIdx.x; e < 64; e += F.G) {
        const int nt_e = (cnt[e] + 255) >> 8;
        for (int i = cnt[e] + F.tid; i < nt_e * 256; i += NWAVES * 64) { tok[rstart[e] + i] = 0; gate[rstart[e] + i] = 0.f; }
        for (int i = F.tid; i < nt_e; i += NWAVES * 64) tile_e[tstart[e] + i] = e;
    }
    for (int i = blockIdx.x * (NWAVES * 64) + F.tid; i < T; i += F.G * NWAVES * 64) { tok[rpad + i] = i; gate[rpad + i] = 1.f; }
    if (blockIdx.x == 0 && F.tid < 64) tile_e[ntr + F.tid] = 64;
}

typedef float f32x2_ __attribute__((ext_vector_type(2)));
template <bool Y8, bool OF32, bool OB16, bool OB8 = false>
__device__ __forceinline__ void combine_ln_phase(Frame& F, int l, const bf16* x1b, float* out, bf16* outb, unsigned char* out8 = nullptr) {
    const int gw = F.vcu * NWAVES + F.wave, NGW = F.G * NWAVES, lane = F.lane;
    const int* slot = (const int*)(F.ws + WS_SLOT); const unsigned char* yp = F.ws + WS_YP; const float* wts = (const float*)(F.ws + WS_WTS);
    const int rpad = (int)__hip_atomic_load(F.ctl + CW_NT + 2 + l, RLX_AGENT);
    const float* g = F.in[16] + l * D; const float* bta = F.in[17] + l * D;
    constexpr float YS = Y8 ? (1.f / 16.f) : 1.f; constexpr int YB = Y8 ? 1 : 2;
    LAS f32x4* gl = (LAS f32x4*)(F.lds + RING_OFF + 98304); LAS f32x4* bl = gl + D / 4;
    gl[F.tid] = ((const GAS f32x4*)g)[F.tid]; bl[F.tid] = ((const GAS f32x4*)bta)[F.tid];
    __syncthreads();
    for (int row = gw; row < T; row += NGW) {
        float v[4][8];
#pragma unroll
        for (int j = 0; j < 4; ++j) { const v4u w = *((const GAS v4u*)(x1b + (size_t)row * D) + lane + 64 * j);
            v[j][0] = bf_lo(w.x) * ALPHA; v[j][1] = bf_hi(w.x) * ALPHA; v[j][2] = bf_lo(w.y) * ALPHA; v[j][3] = bf_hi(w.y) * ALPHA;
            v[j][4] = bf_lo(w.z) * ALPHA; v[j][5] = bf_hi(w.z) * ALPHA; v[j][6] = bf_lo(w.w) * ALPHA; v[j][7] = bf_hi(w.w) * ALPHA; }
        int src[9]; float gw_[9];
#pragma unroll
        for (int k = 0; k < 8; ++k) { src[k] = __builtin_amdgcn_readfirstlane(slot[(size_t)row * 8 + k]); gw_[k] = YS * __builtin_bit_cast(float, __builtin_amdgcn_readfirstlane(__builtin_bit_cast(int, wts[(size_t)row * 8 + k]))); }
        src[8] = rpad + row; gw_[8] = YS;
#pragma unroll
        for (int k = 0; k < 9; ++k) { const unsigned char* yr = yp + (size_t)src[k] * (D * YB); const float gk = gw_[k];
#pragma unroll
            for (int j = 0; j < 4; ++j) {
                if constexpr (Y8) { const v2u w = *((const GAS v2u*)yr + lane + 64 * j);
                    const f32x2_ a = __builtin_amdgcn_cvt_pk_f32_fp8((int)w.x, false), b = __builtin_amdgcn_cvt_pk_f32_fp8((int)w.x, true), c = __builtin_amdgcn_cvt_pk_f32_fp8((int)w.y, false), d = __builtin_amdgcn_cvt_pk_f32_fp8((int)w.y, true);
                    v[j][0] += gk * a.x; v[j][1] += gk * a.y; v[j][2] += gk * b.x; v[j][3] += gk * b.y; v[j][4] += gk * c.x; v[j][5] += gk * c.y; v[j][6] += gk * d.x; v[j][7] += gk * d.y; }
                else { const v4u w = *((const GAS v4u*)yr + lane + 64 * j);
                    v[j][0] += gk * bf_lo(w.x); v[j][1] += gk * bf_hi(w.x); v[j][2] += gk * bf_lo(w.y); v[j][3] += gk * bf_hi(w.y); v[j][4] += gk * bf_lo(w.z); v[j][5] += gk * bf_hi(w.z); v[j][6] += gk * bf_lo(w.w); v[j][7] += gk * bf_hi(w.w); } } }
        float s = 0.f;
#pragma unroll
        for (int j = 0; j < 4; ++j)
#pragma unroll
            for (int i = 0; i < 8; ++i) s += v[j][i];
        const float mean = wave_sum(s) * (1.f / D); float s2 = 0.f;
#pragma unroll
        for (int j = 0; j < 4; ++j)
#pragma unroll
            for (int i = 0; i < 8; ++i) { v[j][i] -= mean; s2 += v[j][i] * v[j][i]; }
        const float rstd = 1.f / sqrtf(wave_sum(s2) * (1.f / D) + LN_EPS);
#pragma unroll
        for (int j = 0; j < 4; ++j) { const int c0 = 8 * lane + 512 * j;
            const f32x4 g0 = gl[2 * lane + 128 * j], g1 = gl[2 * lane + 128 * j + 1], b0 = bl[2 * lane + 128 * j], b1 = bl[2 * lane + 128 * j + 1];
            const f32x4 o0 = (f32x4){v[j][0], v[j][1], v[j][2], v[j][3]} * rstd * g0 + b0, o1 = (f32x4){v[j][4], v[j][5], v[j][6], v[j][7]} * rstd * g1 + b1;
            if constexpr (OF32) { GAS f32x4* xo = (GAS f32x4*)(out + (size_t)row * D + c0); xo[0] = o0; xo[1] = o1; }
            if constexpr (OB16) { v4u w; w.x = pk2(o0.x, o0.y); w.y = pk2(o0.z, o0.w); w.z = pk2(o1.x, o1.y); w.w = pk2(o1.z, o1.w); *(GAS v4u*)(outb + (size_t)row * D + c0) = w; }
            if constexpr (OB8) { v2u q; q.x = pg8::pk4_fp8(o0.x, o0.y, o0.z, o0.w); q.y = pg8::pk4_fp8(o1.x, o1.y, o1.z, o1.w); *(GAS v2u*)(out8 + (size_t)row * D + c0) = q; } }
    }
}
#ifndef P1_CVT_LIMIT
#define P1_CVT_LIMIT 1400
#endif
#ifndef CVT_ATT_GROUPS
#define CVT_ATT_GROUPS 20
#endif
#ifndef DOWN_ALIGN
#define DOWN_ALIGN true
#endif
constexpr int TILE_LDS_OFF = 136192;
static_assert(TILE_LDS_OFF + MAXTILES * 4 <= LDS_BYTES && TILE_LDS_OFF >= 135168 + 1024 && 135168 >= MISC_OFF + 128, "LDS map");
struct Args { const float* in[18]; float* out; unsigned char* ws; int ph_lo, ph_hi; };
__global__ void __launch_bounds__(NWAVES * 64, 2) yoco_fwd(Args args) {
    extern __shared__ __attribute__((aligned(16))) unsigned char lds[];
    Frame F;
    F.lds = (LAS unsigned char*)lds;
    F.tid = threadIdx.x; F.lane = F.tid & 63; F.wave = __builtin_amdgcn_readfirstlane(F.tid >> 6);
    F.G = gridDim.x; { const int bx = blockIdx.x; F.vcu = (F.G % 8 == 0) ? (bx % 8) * (F.G / 8) + bx / 8 : bx; }
    unsigned char* ws = args.ws; F.ws = ws;
    F.ctl = (gu32*)(ws + WS_CTL);
#pragma unroll
    for (int i = 0; i < 18; ++i) F.in[i] = args.in[i];
    F.out = args.out;
    for (int u = F.tid; u < (LDS_BYTES - LDSCTL_OFF) / 4; u += NWAVES * 64) ((LAS unsigned*)(F.lds + LDSCTL_OFF))[u] = 0u;
    __syncthreads();
    XcdBarrier bar; bar.bar = (unsigned*)(F.ctl + CW_BAR); bar.x = 0; bar.st = nullptr;
    if (!MK_PER_PHASE) bar = xcd_barrier_post((unsigned*)(F.ctl + CW_BAR), (volatile LAS unsigned*)(F.lds + MISC_OFF) + 8);
    const int lo = args.ph_lo, hi = args.ph_hi;
#define IN(k) (lo <= (k) && (k) < hi)
#define SEAM(k) do { if (IN(k) && IN((k) + 1)) xcd_barrier(bar); } while (0)
#ifndef DUP_MASK
#define DUP_MASK 0
#endif
#define DUP(k) ((DUP_MASK >> (k)) & 1)
#define REP(k) _Pragma("unroll") for (int rep_ = 0; rep_ <= DUP(k); ++rep_)
    bf16* XB = (bf16*)(ws + WS_XB); bf16* QB = (bf16*)(ws + WS_QB); bf16* KB = (bf16*)(ws + WS_KB); bf16* VB = (bf16*)(ws + WS_VB); bf16* AO = (bf16*)(ws + WS_AO);
    bf16* HM = (bf16*)(ws + WS_Y1);
    unsigned char* X1Q = ws + WS_X1; bf16* X1B = (bf16*)(ws + WS_X1B); bf16* ACT = (bf16*)(ws + WS_ACT); bf16* YP = (bf16*)(ws + WS_YP); float* X2 = (float*)(ws + WS_X2);
    const int* tokp = (const int*)(ws + WS_TOK); const float* gatep = (const float*)(ws + WS_GATE); const int* tile_e = (const int*)(ws + WS_TILE);

    if (IN(0)) REP(0) { if (rep_) xcd_barrier(bar); asm volatile("" : "+v"(F.tid)); F.lane = F.tid & 63; p0_prologue(F); } SEAM(0);
    if (IN(1)) REP(1) { if (rep_) xcd_barrier(bar); asm volatile("" : "+v"(F.tid)); F.lane = F.tid & 63;
        p1_scan(F);
        if (F.G == 256 && P1_CVT_LIMIT > 0 && (int)(blockIdx.x >> 3) >= 24) { if (rep_ == 0) convert_weights<true>(F, (LAS float*)(F.lds + RING_OFF + F.wave * 16384), P1_CVT_LIMIT); }
        else {
        pg8::StaticOrder S; S.init(T, NQKV_A, (F.G == 256 && P1_CVT_LIMIT > 0) ? 192 : F.G, (int)blockIdx.x);
        if constexpr ((ATT8_MASK & 8) != 0) { pg8::Gemm g{(const bf16*)X1Q, (const bf16*)(ws + WS_WQKV_A), D / 2, nullptr};
            pg8::EpiQKVn8 E{QB, (size_t)(WS_KB - WS_QB) / 2, QSCALE_A, (float*)(ws + WS_NRM), (float*)(ws + WS_NRM) + 64 * SEQ};
            pg8::gemm_phase<pg8::EpiQKVn8, pg8::StaticOrder, true, false, true>(F.lds + RING_OFF, g, S, E); }
        else { pg8::Gemm g{XB, (const bf16*)(ws + WS_WQKV_A), D, nullptr};
            pg8::EpiQKVn E{QB, (size_t)(WS_KB - WS_QB) / 2, QSCALE_A, (float*)(ws + WS_NRM), (float*)(ws + WS_NRM) + 64 * SEQ};
            pg8::gemm_phase<pg8::EpiQKVn, pg8::StaticOrder, true, false>(F.lds + RING_OFF, g, S, E); }
        }
    } SEAM(1);
    if (IN(2)) REP(2) { if (rep_) xcd_barrier(bar); asm volatile("" : "+v"(F.tid)); F.lane = F.tid & 63;
        for (int L = blockIdx.x; L < 1024; L += F.G) fox::fox_jlo_item((char*)lds + RING_OFF, L, (const float*)(ws + WS_CB), (const float*)(ws + WS_NRM), (const float*)(ws + WS_NRM) + 64 * SEQ, (int*)(ws + WS_NRM + 2 * 64 * SEQ * 4)); } SEAM(2);
    if (IN(3)) for (int rep_ = 0, nrep_ = (DUP(3) && hi >= N_PHASES) ? 2 : 1; rep_ < nrep_; ++rep_) { if (rep_) xcd_barrier(bar); asm volatile("" : "+v"(F.tid)); F.lane = F.tid & 63;
        const bool att_first = (int)(blockIdx.x >> 3) < CVT_ATT_GROUPS;
        if (!att_first && rep_ == 0) convert_weights<true>(F, (LAS float*)(F.lds + RING_OFF + F.wave * 16384));
        fox::fox_phase((char*)lds + RING_OFF, (const fox::bf16*)QB, (const fox::bf16*)KB, (const fox::bf16*)VB, (fox::bf16*)AO, (const float*)(ws + WS_CB), (unsigned*)(F.ctl + CW_FOXQ), (const int*)(ws + WS_NRM + 2 * 64 * SEQ * 4));
        __syncthreads();
        if (att_first && rep_ == 0) convert_weights<true>(F, (LAS float*)(F.lds + RING_OFF + F.wave * 16384)); } SEAM(3);
    if (IN(4)) REP(4) { if (rep_) xcd_barrier(bar); asm volatile("" : "+v"(F.tid)); F.lane = F.tid & 63;
        pg8::StaticOrder S; S.init(T, D, F.G, (int)blockIdx.x);
        if constexpr ((ATT8_MASK & 4) != 0) { pg8::Gemm g{AO, (const bf16*)(ws + WS_WO_A), D / 2, nullptr}; pg8::EpiBf16A8 E{HM, D, 0, 0, 1.f};
            pg8::gemm_phase<pg8::EpiBf16A8, pg8::StaticOrder, true, false, true>(F.lds + RING_OFF, g, S, E); }
        else { pg8::Gemm g{AO, (const bf16*)(ws + WS_WO_A), D, nullptr}; pg8::EpiBf16 E{HM, D, 0, 0, 1.f};
            pg8::gemm_phase<pg8::EpiBf16, pg8::StaticOrder, true, false>(F.lds + RING_OFF, g, S, E); }
    } SEAM(4);
    if (IN(5)) REP(5) { if (rep_) xcd_barrier(bar); asm volatile("" : "+v"(F.tid)); F.lane = F.tid & 63; ln_router_phase<true>(F, 0, F.in[0], HM, X1B, (FP8_MASK & 1) ? X1Q : nullptr); } SEAM(5);
    if (IN(6)) REP(6) { if (rep_) xcd_barrier(bar); asm volatile("" : "+v"(F.tid)); F.lane = F.tid & 63; dispatch_phase(F, 0); } SEAM(6);
    if (IN(7)) REP(7) { if (rep_) xcd_barrier(bar); asm volatile("" : "+v"(F.tid)); F.lane = F.tid & 63;
        const int ntl = (int)__hip_atomic_load(F.ctl + CW_NT + 0, RLX_AGENT);
        { LAS int* tl_ = (LAS int*)(F.lds + TILE_LDS_OFF); for (int i_ = F.tid; i_ < ntl; i_ += NWAVES * 64) tl_[i_] = tile_e[i_]; __syncthreads(); }
        pg8::GroupedOrder S; S.init(ntl, 4, F.G, (int)blockIdx.x, (const LAS int*)(F.lds + TILE_LDS_OFF));
        if constexpr ((FP8_MASK >> 0) & 1) { pg8::Gemm g{(const bf16*)X1Q, (const bf16*)(ws + WS_WGU), D / 2, tokp}; pg8::EpiSwiglu8 E{(unsigned char*)ACT, EH, 1.f};
            pg8::gemm_phase<pg8::EpiSwiglu8, pg8::GroupedOrder, true, true, true>(F.lds + RING_OFF, g, S, E); }
        else { pg8::Gemm g{X1B, (const bf16*)(ws + WS_WGU), D, tokp}; pg8::EpiSwiglu E{ACT, EH};
            pg8::gemm_phase<pg8::EpiSwiglu, pg8::GroupedOrder, true, true>(F.lds + RING_OFF, g, S, E); }
    } SEAM(7);
    if (IN(8)) REP(8) { if (rep_) xcd_barrier(bar); asm volatile("" : "+v"(F.tid)); F.lane = F.tid & 63;
        const int ntl = (int)__hip_atomic_load(F.ctl + CW_NT + 0, RLX_AGENT);
        { LAS int* tl_ = (LAS int*)(F.lds + TILE_LDS_OFF); for (int i_ = F.tid; i_ < ntl; i_ += NWAVES * 64) tl_[i_] = tile_e[i_]; __syncthreads(); }
        pg8::GroupedOrder S; S.init(ntl, 8, F.G, (int)blockIdx.x, (const LAS int*)(F.lds + TILE_LDS_OFF));
        if constexpr ((FP8_MASK >> 0) & 1) { pg8::Gemm g{ACT, (const bf16*)(ws + WS_WD), EH / 2, nullptr}; pg8::EpiFp8Y E{(unsigned char*)YP, D};
            pg8::gemm_phase<pg8::EpiFp8Y, pg8::GroupedOrder, DOWN_ALIGN, false, true>(F.lds + RING_OFF, g, S, E); }
        else { pg8::Gemm g{ACT, (const bf16*)(ws + WS_WD), EH, nullptr}; pg8::EpiBf16NT E{YP, D, 0, 0, 1.f};
            pg8::gemm_phase<pg8::EpiBf16NT, pg8::GroupedOrder, DOWN_ALIGN, false>(F.lds + RING_OFF, g, S, E); }
    } SEAM(8);
    if (IN(9)) REP(9) { if (rep_) xcd_barrier(bar); asm volatile("" : "+v"(F.tid)); F.lane = F.tid & 63; combine_ln_phase<(FP8_MASK & 1) != 0, false, true, (ATT8_MASK & 2) != 0>(F, 0, X1B, nullptr, XB, X1Q); } SEAM(9);
    if (IN(10)) REP(10) { if (rep_) xcd_barrier(bar); asm volatile("" : "+v"(F.tid)); F.lane = F.tid & 63;
        pg8::StaticOrder S; S.init(T, NQKV_B, F.G, (int)blockIdx.x);
        if constexpr ((ATT8_MASK & 2) != 0) { pg8::Gemm g{(const bf16*)X1Q, (const bf16*)(ws + WS_WQKV_B), D / 2, nullptr};
            pg8::EpiRope8 E{QB, KB, KB + (size_t)T * 256, (const float*)(ws + WS_ROPE), (const float*)(ws + WS_ROPE) + SEQ * 32, QSCALE_B};
            pg8::gemm_phase<pg8::EpiRope8, pg8::StaticOrder, true, false, true>(F.lds + RING_OFF, g, S, E); }
        else { pg8::Gemm g{XB, (const bf16*)(ws + WS_WQKV_B), D, nullptr};
            pg8::EpiRope E{QB, KB, KB + (size_t)T * 256, (const float*)(ws + WS_ROPE), (const float*)(ws + WS_ROPE) + SEQ * 32, QSCALE_B};
            pg8::gemm_phase<pg8::EpiRope, pg8::StaticOrder, true, false>(F.lds + RING_OFF, g, S, E); }
    } SEAM(10);
    if (IN(11)) REP(11) { if (rep_) xcd_barrier(bar); asm volatile("" : "+v"(F.tid)); F.lane = F.tid & 63; swa::swa_phase<(ATT8_MASK & 1) != 0>((char*)lds + RING_OFF, (const swa::bf16*)QB, (const swa::bf16*)KB, (const swa::bf16*)(KB + (size_t)T * 256), (swa::bf16*)AO, F.in[6], (int)blockIdx.x, F.G); } SEAM(11);
    if (IN(12)) REP(12) { if (rep_) xcd_barrier(bar); asm volatile("" : "+v"(F.tid)); F.lane = F.tid & 63;
        pg8::StaticOrder S; S.init(T, D, F.G, (int)blockIdx.x);
        if constexpr (ATT8_MASK & 1) { pg8::Gemm g{AO, (const bf16*)(ws + WS_WO_B), D / 2, nullptr}; pg8::EpiBf16A8 E{HM, D, 0, 0, 1.f};
            pg8::gemm_phase<pg8::EpiBf16A8, pg8::StaticOrder, true, false, true>(F.lds + RING_OFF, g, S, E); }
        else { pg8::Gemm g{AO, (const bf16*)(ws + WS_WO_B), D, nullptr}; pg8::EpiBf16 E{HM, D, 0, 0, 1.f};
            pg8::gemm_phase<pg8::EpiBf16, pg8::StaticOrder, true, false>(F.lds + RING_OFF, g, S, E); }
    } SEAM(12);
    if (IN(13)) REP(13) { if (rep_) xcd_barrier(bar); asm volatile("" : "+v"(F.tid)); F.lane = F.tid & 63; ln_router_phase<false>(F, 1, XB, HM, X1B, (FP8_MASK & 2) ? X1Q : nullptr); } SEAM(13);
    if (IN(14)) REP(14) { if (rep_) xcd_barrier(bar); asm volatile("" : "+v"(F.tid)); F.lane = F.tid & 63; dispatch_phase(F, 1); } SEAM(14);
    if (IN(15)) REP(15) { if (rep_) xcd_barrier(bar); asm volatile("" : "+v"(F.tid)); F.lane = F.tid & 63;
        const int ntl = (int)__hip_atomic_load(F.ctl + CW_NT + 1, RLX_AGENT);
        { LAS int* tl_ = (LAS int*)(F.lds + TILE_LDS_OFF); for (int i_ = F.tid; i_ < ntl; i_ += NWAVES * 64) tl_[i_] = tile_e[i_]; __syncthreads(); }
        pg8::GroupedOrder S; S.init(ntl, 4, F.G, (int)blockIdx.x, (const LAS int*)(F.lds + TILE_LDS_OFF));
        if constexpr ((FP8_MASK >> 1) & 1) { pg8::Gemm g{(const bf16*)X1Q, (const bf16*)(ws + WS_WGU + WGU_L), D / 2, tokp}; pg8::EpiSwiglu8 E{(unsigned char*)ACT, EH, 1.f};
            pg8::gemm_phase<pg8::EpiSwiglu8, pg8::GroupedOrder, true, true, true>(F.lds + RING_OFF, g, S, E); }
        else { pg8::Gemm g{X1B, (const bf16*)(ws + WS_WGU + WGU_L), D, tokp}; pg8::EpiSwiglu E{ACT, EH};
            pg8::gemm_phase<pg8::EpiSwiglu, pg8::GroupedOrder, true, true>(F.lds + RING_OFF, g, S, E); }
    } SEAM(15);
    if (IN(16)) REP(16) { if (rep_) xcd_barrier(bar); asm volatile("" : "+v"(F.tid)); F.lane = F.tid & 63;
        const int ntl = (int)__hip_atomic_load(F.ctl + CW_NT + 1, RLX_AGENT);
        { LAS int* tl_ = (LAS int*)(F.lds + TILE_LDS_OFF); for (int i_ = F.tid; i_ < ntl; i_ += NWAVES * 64) tl_[i_] = tile_e[i_]; __syncthreads(); }
        pg8::GroupedOrder S; S.init(ntl, 8, F.G, (int)blockIdx.x, (const LAS int*)(F.lds + TILE_LDS_OFF));
        if constexpr ((FP8_MASK >> 1) & 1) { pg8::Gemm g{ACT, (const bf16*)(ws + WS_WD + WD_L), EH / 2, nullptr}; pg8::EpiFp8Y E{(unsigned char*)YP, D};
            pg8::gemm_phase<pg8::EpiFp8Y, pg8::GroupedOrder, DOWN_ALIGN, false, true>(F.lds + RING_OFF, g, S, E); }
        else { pg8::Gemm g{ACT, (const bf16*)(ws + WS_WD + WD_L), EH, nullptr}; pg8::EpiBf16NT E{YP, D, 0, 0, 1.f};
            pg8::gemm_phase<pg8::EpiBf16NT, pg8::GroupedOrder, DOWN_ALIGN, false>(F.lds + RING_OFF, g, S, E); }
    } SEAM(16);
    if (IN(17)) REP(17) { if (rep_) xcd_barrier(bar); asm volatile("" : "+v"(F.tid)); F.lane = F.tid & 63; combine_ln_phase<(FP8_MASK & 2) != 0, true, false>(F, 1, X1B, F.out, nullptr); }
#undef IN
#undef SEAM
}

#ifndef HOST_DUP_MASK
#define HOST_DUP_MASK 0
#endif
extern "C" void kernel_launch(void* const* d_in, const int* in_sizes, int n_in, void* d_out, int out_size, void* d_ws, size_t ws_size, hipStream_t stream) {
    static int grid = 0;
    if (grid == 0) {
        if (n_in != 18 || in_sizes[0] != T * D || out_size != T * D || ws_size < WS_END) { fprintf(stderr, "kernel_launch: unexpected shapes (n_in %d, in0 %d, out %d, ws %zu); nothing launched\n", n_in, n_in > 0 ? in_sizes[0] : -1, out_size, ws_size); grid = -1; return; }
        int dev = 0, cus = 0, per_cu = 0;
        if (hipGetDevice(&dev) != hipSuccess || hipDeviceGetAttribute(&cus, hipDeviceAttributeMultiprocessorCount, dev) != hipSuccess) { grid = -1; return; }
        if (hipFuncSetAttribute((const void*)yoco_fwd, hipFuncAttributeMaxDynamicSharedMemorySize, LDS_BYTES) != hipSuccess) { fprintf(stderr, "kernel_launch: hipFuncSetAttribute failed\n"); grid = -1; return; }
        if (hipOccupancyMaxActiveBlocksPerMultiprocessor(&per_cu, (const void*)yoco_fwd, NWAVES * 64, LDS_BYTES) != hipSuccess || per_cu < 1)
            fprintf(stderr, "kernel_launch: note: occupancy query reports %d workgroups per CU\n", per_cu);
        (void)hipGetLastError();
        grid = cus;
    }
    if (grid < 0) return;
    if (hipMemsetAsync((char*)d_ws + WS_CTL, 0, CTL_ZERO_BYTES, stream) != hipSuccess) return;
    Args a{};
    for (int i = 0; i < 18; ++i) a.in[i] = (const float*)d_in[i];
    a.out = (float*)d_out; a.ws = (unsigned char*)d_ws;
#if MK_PER_PHASE
    for (int p = 0; p < N_PHASES; ++p) for (int r = 0; r <= ((HOST_DUP_MASK >> p) & 1); ++r) { a.ph_lo = p; a.ph_hi = p + 1; hipLaunchKernelGGL(yoco_fwd, dim3(grid), dim3(NWAVES * 64), LDS_BYTES, stream, a); }
#else
    a.ph_lo = 0; a.ph_hi = N_PHASES;
    hipLaunchKernelGGL(yoco_fwd, dim3(grid), dim3(NWAVES * 64), LDS_BYTES, stream, a);
#endif
    const hipError_t le = hipPeekAtLastError();
    if (le != hipSuccess) fprintf(stderr, "kernel_launch: launch failed: %s\n", hipGetErrorName(le));
}
```
